# Optimizing an MI355X kernel written in HIP

```python
import jax, jax.numpy as jnp
from jax import lax
import numpy as np

D_MODEL = 2048
BATCH = 2
SEQ = 8192
DEPTH = 1

NSA_HEADS = 16
NSA_KV_GROUPS = 4
NSA_HPG = NSA_HEADS // NSA_KV_GROUPS
NSA_HEAD_DIM = 64
CMP_BLOCK = 32
CMP_STRIDE = 16
CMP_HIDDEN = 256
SLC_BLOCK = 64
N_SELECT = 16
WINDOW = 512
Q_BLOCK = 128
NSA_WIDTH = NSA_HEADS * NSA_HEAD_DIM
NSA_KV_WIDTH = NSA_KV_GROUPS * NSA_HEAD_DIM
GLA_HEADS = 4
GLA_KEY_DIM = 128
GLA_VAL_DIM = 256
GLA_GATE_RANK = 16
GLA_TAU = 16.0
GLA_CHUNK = 64
GLA_KEY_WIDTH = GLA_HEADS * GLA_KEY_DIM
GLA_WIDTH = GLA_HEADS * GLA_VAL_DIM
IN_WIDTHS = (NSA_WIDTH,
             NSA_KV_WIDTH, NSA_KV_WIDTH,
             NSA_KV_WIDTH, NSA_KV_WIDTH,
             NSA_KV_WIDTH, NSA_KV_WIDTH,
             3 * NSA_HEADS,
             NSA_WIDTH,
             GLA_KEY_WIDTH, GLA_KEY_WIDTH, GLA_WIDTH,
             GLA_GATE_RANK,
             GLA_WIDTH,
             D_MODEL, D_MODEL)
IN_WIDTH = sum(IN_WIDTHS)
EPS = 1e-6
NEG = -1e30

kernel_name = "hybrid_nsa_gla_gated_merge"


def rmsnorm(x, g):
    xf = x.astype(jnp.float32)
    y = xf * lax.rsqrt(jnp.mean(xf * xf, axis=-1, keepdims=True) + EPS)
    return (y * g.astype(jnp.float32)).astype(x.dtype)


def split_cols(a, widths):
    offs = np.cumsum(np.array(widths))[:-1].tolist()
    return jnp.split(a, offs, axis=-1)


def alibi_slopes(n):
    return 2.0 ** (-8.0 * jnp.arange(1, n + 1, dtype=jnp.float32) / n)


def masked_softmax(s, valid):
    p = jax.nn.softmax(jnp.where(valid, s, NEG), axis=-1)
    return jnp.where(jnp.any(valid, axis=-1, keepdims=True), p, 0.0)


def compress(kv, pos_emb, w1, w2):
    B, G, T, DH = kv.shape
    n_sub = CMP_BLOCK // CMP_STRIDE
    n_chunks = T // CMP_STRIDE
    nc = n_chunks - n_sub + 1
    chunks = kv.reshape(B, G, n_chunks, CMP_STRIDE, DH)
    blocks = jnp.concatenate([chunks[:, :, j:j + nc] for j in range(n_sub)], axis=3)
    blocks = blocks + pos_emb
    flat = blocks.reshape(B, G, nc, CMP_BLOCK * DH)
    return jax.nn.silu(flat @ w1) @ w2


def window_bands(a):
    B, G, T, DH = a.shape
    nq = T // Q_BLOCK
    nw = WINDOW // Q_BLOCK
    ap = jnp.pad(a, ((0, 0), (0, 0), (WINDOW, 0), (0, 0))).reshape(B, G, nq + nw, Q_BLOCK, DH)
    band = jnp.stack([ap[:, :, j:j + nq] for j in range(nw + 1)], axis=3)
    return jnp.moveaxis(band.reshape(B, G, nq, (nw + 1) * Q_BLOCK, DH), 2, 0)


def to_query_blocks(a):
    B, G, HPG, T, X = a.shape
    return jnp.moveaxis(a.reshape(B, G, HPG, T // Q_BLOCK, Q_BLOCK, X), 3, 0)


def nsa_attention(q, k_cmp, v_cmp, k_slc, v_slc, k_win, v_win, gates,
                  pos_k, pos_v, w1_k, w2_k, w1_v, w2_v):
    B, G, HPG, T, DH = q.shape
    nq = T // Q_BLOCK
    scale = DH ** -0.5
    slopes = alibi_slopes(NSA_HEADS).reshape(G, HPG)[None, :, :, None, None]
    Kc = compress(k_cmp, pos_k, w1_k, w2_k)
    Vc = compress(v_cmp, pos_v, w1_v, w2_v)
    nc = Kc.shape[2]
    cmp_end = jnp.arange(nc) * CMP_STRIDE + CMP_BLOCK - 1
    nb = T // SLC_BLOCK
    n_sel = min(N_SELECT, nb)
    Ks = k_slc.reshape(B, G, nb, SLC_BLOCK, DH)
    Vs = v_slc.reshape(B, G, nb, SLC_BLOCK, DH)
    ratio = SLC_BLOCK // CMP_STRIDE
    n_sub = CMP_BLOCK // CMP_STRIDE
    gather = jax.vmap(jax.vmap(lambda blk, ix: blk[ix]))
    blk_ids = jnp.arange(nb)

    def block_fn(args):
        i, qi, gi, kwi, vwi = args
        t = i * Q_BLOCK + jnp.arange(Q_BLOCK)
        tf = t.astype(jnp.float32)
        dist = tf[:, None] - cmp_end[None, :].astype(jnp.float32)
        s = jnp.einsum('bghqd,bgnd->bghqn', qi, Kc).astype(jnp.float32) * scale - slopes * dist
        p_cmp = masked_softmax(s, cmp_end[None, :] <= t[:, None])
        o_cmp = jnp.einsum('bghqn,bgnd->bghqd', p_cmp.astype(Vc.dtype), Vc)
        P = jnp.sum(p_cmp, axis=2)
        Ppad = jnp.pad(P, ((0, 0), (0, 0), (0, 0), (n_sub - 1, ratio * nb - nc)))
        imp = jnp.zeros(P.shape[:3] + (nb,), jnp.float32)
        for m in range(ratio):
            for n in range(n_sub):
                st = m - n + n_sub - 1
                imp = imp + lax.slice_in_dim(Ppad, st, st + ratio * (nb - 1) + 1, stride=ratio, axis=3)
        cur = t // SLC_BLOCK
        forced = (blk_ids[None, :] == 0) | (blk_ids[None, :] == cur[:, None]) | (blk_ids[None, :] == cur[:, None] - 1)
        blk_valid = blk_ids[None, :] * SLC_BLOCK <= t[:, None]
        score = jnp.where(forced, jnp.inf, jnp.where(blk_valid, imp, -jnp.inf))
        _, idx = lax.top_k(score, n_sel)
        ksel = gather(Ks, idx).reshape(B, G, Q_BLOCK, n_sel * SLC_BLOCK, DH)
        vsel = gather(Vs, idx).reshape(B, G, Q_BLOCK, n_sel * SLC_BLOCK, DH)
        spos = (idx[..., None] * SLC_BLOCK + jnp.arange(SLC_BLOCK)).reshape(B, G, Q_BLOCK, n_sel * SLC_BLOCK)
        dist = (tf[:, None] - spos.astype(jnp.float32))[:, :, None]
        s = jnp.einsum('bghqd,bgqkd->bghqk', qi, ksel).astype(jnp.float32) * scale - slopes * dist
        p = masked_softmax(s, (spos <= t[:, None])[:, :, None])
        o_slc = jnp.einsum('bghqk,bgqkd->bghqd', p.astype(vsel.dtype), vsel)
        wpos = i * Q_BLOCK - WINDOW + jnp.arange(Q_BLOCK + WINDOW)
        diff = t[:, None] - wpos[None, :]
        valid = (diff >= 0) & (diff < WINDOW) & (wpos[None, :] >= 0)
        s = jnp.einsum('bghqd,bgkd->bghqk', qi, kwi).astype(jnp.float32) * scale - slopes * diff.astype(jnp.float32)
        p = masked_softmax(s, valid)
        o_win = jnp.einsum('bghqk,bgkd->bghqd', p.astype(vwi.dtype), vwi)
        return gi[..., 0:1] * o_cmp + gi[..., 1:2] * o_slc + gi[..., 2:3] * o_win

    out = lax.map(block_fn, (jnp.arange(nq), to_query_blocks(q), to_query_blocks(gates),
                             window_bands(k_win), window_bands(v_win)))
    return out.transpose(1, 0, 4, 2, 3, 5).reshape(B, T, G * HPG * DH)


def gla_attention(q, k, v, log_a):
    B, T, H, DK = q.shape
    DV = v.shape[-1]
    n = T // GLA_CHUNK
    causal = jnp.tril(jnp.ones((GLA_CHUNK, GLA_CHUNK), dtype=bool))[..., None]

    def chunks(a):
        return a.reshape(B, n, GLA_CHUNK, H, a.shape[-1]).transpose(1, 0, 3, 2, 4)

    def step(S, inp):
        qc, kc, vc, gc = inp
        b = jnp.cumsum(gc, axis=2)
        rel = jnp.where(causal, b[:, :, :, None, :] - b[:, :, None, :, :], -jnp.inf)
        A = jnp.einsum('bhik,bhjk,bhijk->bhij', qc, kc, jnp.exp(rel))
        o = jnp.einsum('bhij,bhjv->bhiv', A, vc) + jnp.einsum('bhik,bhkv->bhiv', qc * jnp.exp(b), S)
        b_last = b[:, :, -1:, :]
        S = jnp.exp(b_last)[:, :, 0, :, None] * S + jnp.einsum('bhjk,bhjv->bhkv', kc * jnp.exp(b_last - b), vc)
        return S, o

    S0 = jnp.zeros((B, H, DK, DV), jnp.float32)
    _, o = lax.scan(step, S0, (chunks(q * (DK ** -0.5)), chunks(k), chunks(v), chunks(log_a)))
    return o.transpose(1, 0, 3, 2, 4).reshape(B, T, H, DV)


def setup_inputs(seed: int = 0) -> dict:
    key = jax.random.key(seed)
    ks = jax.random.split(key, 22)
    L = DEPTH

    def nrm(k, shape, s):
        return jax.random.normal(k, shape, jnp.float32) * s

    return {
        "x": nrm(ks[0], (BATCH, SEQ, D_MODEL), 1.0),
        "c": nrm(ks[1], (BATCH, D_MODEL), 1.0),
        "w_ada": nrm(ks[2], (L, D_MODEL, 3 * D_MODEL), 0.3 * D_MODEL ** -0.5),
        "b_ada": nrm(ks[3], (L, 3 * D_MODEL), 0.01),
        "norm_gain": 1.0 + nrm(ks[4], (L, D_MODEL), 0.02),
        "w_in": nrm(ks[5], (L, D_MODEL, IN_WIDTH), D_MODEL ** -0.5),
        "b_in": nrm(ks[6], (L, IN_WIDTH), 0.01),
        "cmp_pos_k": nrm(ks[7], (L, CMP_BLOCK, NSA_HEAD_DIM), 0.02),
        "cmp_pos_v": nrm(ks[8], (L, CMP_BLOCK, NSA_HEAD_DIM), 0.02),
        "cmp_w1_k": nrm(ks[9], (L, CMP_BLOCK * NSA_HEAD_DIM, CMP_HIDDEN), (CMP_BLOCK * NSA_HEAD_DIM) ** -0.5),
        "cmp_w2_k": nrm(ks[10], (L, CMP_HIDDEN, NSA_HEAD_DIM), CMP_HIDDEN ** -0.5),
        "cmp_w1_v": nrm(ks[11], (L, CMP_BLOCK * NSA_HEAD_DIM, CMP_HIDDEN), (CMP_BLOCK * NSA_HEAD_DIM) ** -0.5),
        "cmp_w2_v": nrm(ks[12], (L, CMP_HIDDEN, NSA_HEAD_DIM), CMP_HIDDEN ** -0.5),
        "gla_w_alpha": nrm(ks[13], (L, GLA_GATE_RANK, GLA_KEY_WIDTH), GLA_GATE_RANK ** -0.5),
        "gla_b_alpha": nrm(ks[14], (L, GLA_KEY_WIDTH), 0.01),
        "gla_norm_gain": 1.0 + nrm(ks[15], (L, GLA_VAL_DIM), 0.02),
        "w_br_nsa": nrm(ks[16], (L, NSA_WIDTH, D_MODEL), NSA_WIDTH ** -0.5),
        "w_br_gla": nrm(ks[17], (L, GLA_WIDTH, D_MODEL), GLA_WIDTH ** -0.5),
        "w_out": nrm(ks[18], (L, D_MODEL, D_MODEL), D_MODEL ** -0.5),
        "final_norm_gain": 1.0 + nrm(ks[19], (D_MODEL,), 0.02),
    }


def reference(x, c, w_ada, b_ada, norm_gain, w_in, b_in, cmp_pos_k, cmp_pos_v,
              cmp_w1_k, cmp_w2_k, cmp_w1_v, cmp_w2_v, gla_w_alpha, gla_b_alpha,
              gla_norm_gain, w_br_nsa, w_br_gla, w_out, final_norm_gain):
    B, T, D = x.shape
    G, HPG, DH = NSA_KV_GROUPS, NSA_HPG, NSA_HEAD_DIM

    def kv_heads(a):
        return a.reshape(B, T, G, DH).transpose(0, 2, 1, 3)

    for l in range(DEPTH):
        shift, scale, gate = jnp.split(c @ w_ada[l] + b_ada[l], 3, axis=-1)
        h = rmsnorm(x, norm_gain[l]) * (1.0 + scale[:, None, :]) + shift[:, None, :]
        (nsa_q, ck, cv, sk, sv, wk, wv, nsa_g, nsa_z,
         gq, gk, gv, ga, gla_z, mg_nsa, mg_gla) = split_cols(h @ w_in[l] + b_in[l], IN_WIDTHS)
        q = nsa_q.reshape(B, T, G, HPG, DH).transpose(0, 2, 3, 1, 4)
        bgates = jax.nn.sigmoid(nsa_g).reshape(B, T, G, HPG, 3).transpose(0, 2, 3, 1, 4)
        o_nsa = nsa_attention(q, kv_heads(ck), kv_heads(cv), kv_heads(sk), kv_heads(sv),
                              kv_heads(wk), kv_heads(wv), bgates,
                              cmp_pos_k[l], cmp_pos_v[l], cmp_w1_k[l], cmp_w2_k[l],
                              cmp_w1_v[l], cmp_w2_v[l])
        y_nsa = o_nsa * jax.nn.silu(nsa_z)
        log_a = jax.nn.log_sigmoid((ga @ gla_w_alpha[l] + gla_b_alpha[l]).astype(jnp.float32)) / GLA_TAU
        o_gla = gla_attention(gq.reshape(B, T, GLA_HEADS, GLA_KEY_DIM),
                              gk.reshape(B, T, GLA_HEADS, GLA_KEY_DIM),
                              gv.reshape(B, T, GLA_HEADS, GLA_VAL_DIM),
                              log_a.reshape(B, T, GLA_HEADS, GLA_KEY_DIM)).astype(x.dtype)
        y_gla = rmsnorm(o_gla, gla_norm_gain[l]).reshape(B, T, GLA_WIDTH) * jax.nn.silu(gla_z)
        merged = jax.nn.sigmoid(mg_nsa) * (y_nsa @ w_br_nsa[l]) + jax.nn.sigmoid(mg_gla) * (y_gla @ w_br_gla[l])
        x = x + gate[:, None, :] * (merged @ w_out[l])
    return rmsnorm(x, final_norm_gain)
```

```cpp
#include <hip/hip_runtime.h>
#include <hip/hip_cooperative_groups.h>
#include <cstdio>
#include <cstdint>
namespace cg = cooperative_groups;

#ifndef PROBE_DUP
#define PROBE_DUP 0
#endif
#ifndef MK_CG_SYNC
#define MK_CG_SYNC 0
#endif
#ifndef MK_ONE_LAUNCH
#define MK_ONE_LAUNCH 1
#endif

#define LAS __attribute__((address_space(3)))
typedef unsigned short bf16_t;
typedef short bf16x8 __attribute__((ext_vector_type(8)));
typedef float f32x4 __attribute__((ext_vector_type(4)));
typedef float f32x2 __attribute__((ext_vector_type(2)));
typedef unsigned u32x4 __attribute__((ext_vector_type(4)));
typedef unsigned u32x2 __attribute__((ext_vector_type(2)));

constexpr int T_ = 8192, DM = 2048, NTOK = 16384;
constexpr int NP = 11008, NREAL = 10816;
constexpr int LDPA = 5120, LDPB = 4096;
constexpr int PA_Q = 0, PA_CK = 1024, PA_CV = 1280, PA_SK = 1536, PA_WK = 1792, PA_ZN = 2048, PA_GQ = 3072, PA_GK = 3584, PA_ZG = 4096;
constexpr float LOG2E = 1.4426950408889634f, LN2 = 0.6931471805599453f;
constexpr float QSCALE = 0.125f * LOG2E;
constexpr float EPS_ = 1e-6f;
constexpr int LDS_BYTES = 133376;
constexpr int LDS_XB = 133120;

constexpr size_t al256(size_t x) { return (x + 255) & ~(size_t)255; }
constexpr size_t WS_CTL = 0;
constexpr size_t WS_APART = 16384;
constexpr size_t WS_GATE = WS_APART + al256(32ull * 2 * 6144 * 4);
constexpr size_t WS_BIASP = WS_GATE + al256(2ull * 2048 * 4);
constexpr size_t WS_CB1P = WS_BIASP + al256(11008ull * 4);
constexpr size_t WS_GAM = WS_CB1P + al256(2ull * 8 * 256 * 4);
constexpr size_t WS_SSQ = WS_GAM + al256(8ull * 128 * 128 * 4);
constexpr size_t WS_W2T = WS_SSQ + al256(16384ull * 32 * 4);
constexpr size_t WS_KC = WS_W2T + al256(2ull * 64 * 256 * 2);
constexpr size_t WS_VCT = WS_KC + al256(8ull * 512 * 64 * 2);
constexpr size_t WS_HID = WS_VCT + al256(8ull * 64 * 512 * 2);
constexpr size_t WS_W1T = WS_HID + al256(2ull * 4096 * 256 * 2);
constexpr size_t WS_WTBR = WS_W1T + al256(2ull * 256 * 2048 * 2);
constexpr size_t WS_WTOUT = WS_WTBR + al256(2048ull * 2048 * 2);
constexpr size_t WS_WTIN = WS_WTOUT + al256(2048ull * 2048 * 2);
constexpr size_t WS_SM = WS_WTIN + al256(11008ull * 2048 * 2);
constexpr size_t WS_SVT = WS_SM + al256(16384ull * 64 * 4);
constexpr size_t WS_WVT = WS_SVT + al256(2ull * 256 * 8192 * 2);
constexpr size_t WS_GVT = WS_WVT + al256(2ull * 256 * 8192 * 2);
constexpr size_t WS_HB = WS_GVT + al256(2ull * 1024 * 8192 * 2);
constexpr size_t WS_PA = WS_HB + al256(16384ull * 2048 * 2);
constexpr size_t WS_PB = WS_PA + al256(16384ull * 5120 * 2);
constexpr size_t WS_SKB = WS_PB + al256(16384ull * 4096 * 2);
constexpr size_t WS_WKB = WS_SKB + al256(2ull * 4 * 8192 * 64 * 2);
constexpr size_t WS_END = WS_WKB + al256(2ull * 4 * 8192 * 64 * 2);
static_assert(WS_END <= 512ull * 1024 * 1024, "workspace");

struct Args { const float* in[20]; float* out; unsigned char* ws; int ph_lo, ph_hi; };

typedef __bf16 bf16x2_t __attribute__((ext_vector_type(2)));
__device__ __forceinline__ unsigned pk2(float lo, float hi) { f32x2 v = {lo, hi}; bf16x2_t b = __builtin_convertvector(v, bf16x2_t); return __builtin_bit_cast(unsigned, b); }
__device__ __forceinline__ float bf2f(unsigned short v) { return __uint_as_float(((unsigned)v) << 16); }
__device__ __forceinline__ float bflo(unsigned v) { return __uint_as_float(v << 16); }
__device__ __forceinline__ float bfhi(unsigned v) { return __uint_as_float(v & 0xffff0000u); }
__device__ __forceinline__ float ex2(float x) { return __builtin_amdgcn_exp2f(x); }
__device__ __forceinline__ float fexp(float x) { return __builtin_amdgcn_exp2f(x * LOG2E); }
__device__ __forceinline__ float sigmoidf_(float x) { return __builtin_amdgcn_rcpf(1.f + fexp(-x)); }
__device__ __forceinline__ float siluf_(float x) { return x * sigmoidf_(x); }
__device__ __forceinline__ float wave_sum(float v) {
#pragma unroll
    for (int o = 1; o < 64; o <<= 1) v += __shfl_xor(v, o);
    return v;
}
#define LDS_WAIT() asm volatile("s_waitcnt lgkmcnt(0)" ::: "memory")
__device__ __forceinline__ bf16x8 as_bf16x8(u32x4 v) { union { u32x4 u; bf16x8 b; } x; x.u = v; return x.b; }

namespace pg8 {
constexpr int BM = 256, BK = 64, HALF = 128, HTB = HALF * BK * 2, STAGE_BYTES = 8 * HTB;
__device__ __forceinline__ int lds_byte(int r, int c) { const int st = (r >> 4) * 2 + (c >> 5), rr = r & 15, cc = c & 31, ob = rr * 64 + cc * 2; return st * 1024 + (ob ^ (((ob >> 9) & 1) << 5)); }
__device__ __forceinline__ void stage_rc(int b, int& R, int& C) { const int st = b / 1024, sb = b % 1024, swz = sb ^ (((sb >> 9) & 1) << 5); R = (st >> 1) * 16 + swz / 64; C = (st & 1) * 32 + (swz % 64) / 2; }
__device__ __forceinline__ int perm32(int rho) { const int n = rho >> 4, i = rho & 15; return 8 * (i >> 2) + 4 * n + (i & 3); }
struct Unit { int pm, pn, sub; };

template <class Op, bool SP2, bool ALIGN_EPI = true>
__device__ __forceinline__ void gemm_phase(LAS unsigned char* lds, const Op& O, const int G, const int c) {
    const int tid = threadIdx.x, wid = __builtin_amdgcn_readfirstlane(tid >> 6), lane = tid & 63, wr = wid >> 2, wc = wid & 3, fr = lane & 15, fq = lane >> 4;
    const int nt = O.nt;
    Unit cur, nxt; int ui = 0;
    if (!O.get(0, c, G, cur)) return;
    unsigned voffA[2], voffB[2];
#pragma unroll
    for (int i = 0; i < 2; ++i) { const int bb = tid * 16 + i * 8192; const int R = bb >> 7; const int C = ((((bb >> 4) & 7) ^ ((R >> 1) & 7)) << 3); const int Rb = Op::PERM ? ((R & ~31) + perm32(R & 31)) : R;
        voffA[i] = (unsigned)R * O.lda + (unsigned)C * 2u; voffB[i] = (unsigned)Rb * O.ldb + (unsigned)C * 2u; }
    const size_t kstepA = (size_t)O.akstep, kstepB = (size_t)(BK * 2);
    const size_t hstepA = (size_t)HALF * O.lda, hstepB = (size_t)HALF * O.ldb;
    const unsigned ldsw = (unsigned)wid * 1024u;
    int aoffk[2], boffk[2];
#pragma unroll
    for (int k = 0; k < 2; ++k) { const int pc = ((k * 4 + fq) ^ ((fr >> 1) & 7)) << 4; aoffk[k] = (wr * 64 + fr) * 128 + pc; boffk[k] = (wc * 32 + fr) * 128 + pc; }
#define PG8_SA(b, h) (((b) * 2 + (h)) * HTB)
#define PG8_SB(b, h) ((4 + (b) * 2 + (h)) * HTB)
#define PG8_STAGE(bufoff, gbase, voff) do { _Pragma("unroll") for (int _i = 0; _i < 2; ++_i) \
        __builtin_amdgcn_global_load_lds((const unsigned*)((const char*)(gbase) + (voff)[_i]), (LAS unsigned*)(lds + (bufoff) + ldsw + _i * 8192), 16, 0, 0); } while (0)
#define PG8_LDA(dst, b, h) do { _Pragma("unroll") for (int m = 0; m < 4; ++m) _Pragma("unroll") for (int k = 0; k < 2; ++k) dst[m][k] = *(const LAS bf16x8*)(lds + PG8_SA(b, h) + aoffk[k] + m * 2048); } while (0)
#define PG8_LDB(dst, b, h) do { _Pragma("unroll") for (int n = 0; n < 2; ++n) _Pragma("unroll") for (int k = 0; k < 2; ++k) dst[n][k] = *(const LAS bf16x8*)(lds + PG8_SB(b, h) + boffk[k] + n * 2048); } while (0)
#define PG8_MMA(ai, bj, At, Bt) do { __builtin_amdgcn_s_setprio(1); _Pragma("unroll") for (int m = 0; m < 4; ++m) _Pragma("unroll") for (int n = 0; n < 2; ++n) _Pragma("unroll") for (int k = 0; k < 2; ++k) \
        acc[ai][bj][m][n] = __builtin_amdgcn_mfma_f32_16x16x32_bf16(Bt[n][k], At[m][k], acc[ai][bj][m][n], 0, 0, 0); __builtin_amdgcn_s_setprio(0); } while (0)
#define PG8_WAIT_V(n) asm volatile("s_waitcnt vmcnt(" #n ")" ::: "memory")
#define PG8_WAIT_L(n) asm volatile("s_waitcnt lgkmcnt(" #n ")" ::: "memory")
#define PG8_BAR __builtin_amdgcn_s_barrier()
#define PG8_SCHED __builtin_amdgcn_sched_barrier(0)
    f32x4 acc[2][2][4][2];
#pragma unroll
    for (int a = 0; a < 2; ++a)
#pragma unroll
        for (int b = 0; b < 2; ++b)
#pragma unroll
            for (int m = 0; m < 4; ++m)
#pragma unroll
                for (int n = 0; n < 2; ++n) acc[a][b][m][n] = (f32x4){0.f, 0.f, 0.f, 0.f};
    bf16x8 At[4][2], B0[2][2], B1[2][2];
    const char* cA = O.a_ptr(cur); const char* cB = O.b_ptr(cur);
#define PG8_BIAS(u, slot) do { if constexpr (Op::LDS_BIAS) { if (wid < 4) __builtin_amdgcn_global_load_lds((const unsigned*)(O.bias_ptr(u) + wid * 64 + lane), (LAS unsigned*)(lds + STAGE_BYTES + (slot) * 1024 + wid * 256), 4, 0, 0); } } while (0)
    PG8_BIAS(cur, 0);
    if constexpr (SP2) {
        PG8_STAGE(PG8_SB(0, 0), cB, voffB); PG8_STAGE(PG8_SB(0, 1), cB + hstepB, voffB); PG8_STAGE(PG8_SA(0, 0), cA, voffA); PG8_STAGE(PG8_SA(0, 1), cA + hstepA, voffA);
        if (wr == 1) PG8_BAR;
        PG8_WAIT_V(2); PG8_BAR;
        PG8_STAGE(PG8_SB(1, 0), cB + kstepB, voffB); PG8_STAGE(PG8_SA(1, 0), cA + kstepA, voffA); PG8_STAGE(PG8_SB(1, 1), cB + hstepB + kstepB, voffB);
        PG8_WAIT_V(6); PG8_BAR;
    } else {
        PG8_STAGE(PG8_SB(0, 0), cB, voffB); PG8_STAGE(PG8_SA(0, 0), cA, voffA); PG8_STAGE(PG8_SB(0, 1), cB + hstepB, voffB); PG8_STAGE(PG8_SA(0, 1), cA + hstepA, voffA);
        if (wr == 1) PG8_BAR;
        PG8_WAIT_V(4); PG8_BAR;
        PG8_STAGE(PG8_SB(1, 0), cB + kstepB, voffB); PG8_STAGE(PG8_SA(1, 0), cA + kstepA, voffA); PG8_STAGE(PG8_SB(1, 1), cB + hstepB + kstepB, voffB);
        PG8_WAIT_V(6); PG8_BAR;
    }
    for (;;) {
        const bool has_next = O.get(ui + 1, c, G, nxt);
        const char* nA = has_next ? O.a_ptr(nxt) : cA; const char* nB = has_next ? O.b_ptr(nxt) : cB;
        for (int t = 0; t < nt; t += 2) {
            const bool last = (t == nt - 2);
            const char* a1 = cA + (size_t)(t + 1) * kstepA;
            const char* a2 = last ? nA : cA + (size_t)(t + 2) * kstepA; const char* b2 = last ? nB : cB + (size_t)(t + 2) * kstepB;
            const char* a3 = a2 + kstepA; const char* b3 = b2 + kstepB;
            if constexpr (SP2) {
            PG8_LDB(B0, 0, 0); PG8_LDB(B1, 0, 1); PG8_SCHED; PG8_LDA(At, 0, 0); PG8_STAGE(PG8_SA(1, 1), a1 + hstepA, voffA);
            PG8_WAIT_V(8); PG8_WAIT_L(0); PG8_BAR; PG8_MMA(0, 0, At, B0); PG8_MMA(0, 1, At, B1); PG8_BAR; PG8_SCHED;
            PG8_LDA(At, 0, 1); PG8_STAGE(PG8_SB(0, 0), b2, voffB); PG8_STAGE(PG8_SB(0, 1), b2 + hstepB, voffB); PG8_STAGE(PG8_SA(0, 0), a2, voffA);
            PG8_WAIT_V(8); PG8_WAIT_L(0); PG8_BAR; PG8_MMA(1, 0, At, B0); PG8_MMA(1, 1, At, B1); PG8_BAR; PG8_SCHED;
            PG8_LDB(B0, 1, 0); PG8_LDB(B1, 1, 1); PG8_SCHED; PG8_LDA(At, 1, 0); PG8_STAGE(PG8_SA(0, 1), a2 + hstepA, voffA);
            PG8_WAIT_V(8); PG8_WAIT_L(0); PG8_BAR; PG8_MMA(0, 0, At, B0); PG8_MMA(0, 1, At, B1); PG8_BAR; PG8_SCHED;
            PG8_LDA(At, 1, 1); PG8_STAGE(PG8_SB(1, 0), b3, voffB); PG8_STAGE(PG8_SB(1, 1), b3 + hstepB, voffB); PG8_STAGE(PG8_SA(1, 0), a3, voffA);
            PG8_WAIT_V(8); PG8_WAIT_L(0); PG8_BAR; PG8_MMA(1, 0, At, B0); PG8_MMA(1, 1, At, B1); PG8_BAR; PG8_SCHED;
            } else {
            PG8_LDB(B0, 0, 0); PG8_SCHED; PG8_LDA(At, 0, 0); PG8_STAGE(PG8_SA(1, 1), a1 + hstepA, voffA);
            PG8_WAIT_L(8); PG8_BAR; PG8_WAIT_L(0); PG8_MMA(0, 0, At, B0); PG8_BAR; PG8_SCHED;
            PG8_LDB(B1, 0, 1); PG8_STAGE(PG8_SB(0, 0), b2, voffB);
            PG8_BAR; PG8_WAIT_L(0); PG8_MMA(0, 1, At, B1); PG8_BAR;
            PG8_LDA(At, 0, 1); PG8_STAGE(PG8_SA(0, 0), a2, voffA);
            PG8_BAR; PG8_WAIT_L(0); PG8_MMA(1, 0, At, B0); PG8_BAR; PG8_SCHED;
            PG8_STAGE(PG8_SB(0, 1), b2 + hstepB, voffB);
            PG8_WAIT_V(6); PG8_BAR; PG8_MMA(1, 1, At, B1); PG8_BAR;
            PG8_LDB(B0, 1, 0); PG8_SCHED; PG8_LDA(At, 1, 0); PG8_STAGE(PG8_SA(0, 1), a2 + hstepA, voffA);
            PG8_WAIT_L(8); PG8_BAR; PG8_WAIT_L(0); PG8_MMA(0, 0, At, B0); PG8_BAR; PG8_SCHED;
            PG8_LDB(B1, 1, 1); PG8_STAGE(PG8_SB(1, 0), b3, voffB);
            PG8_BAR; PG8_WAIT_L(0); PG8_MMA(0, 1, At, B1); PG8_BAR;
            PG8_LDA(At, 1, 1); PG8_STAGE(PG8_SA(1, 0), a3, voffA);
            PG8_BAR; PG8_WAIT_L(0); PG8_MMA(1, 0, At, B0); PG8_BAR; PG8_SCHED;
            PG8_STAGE(PG8_SB(1, 1), b3 + hstepB, voffB);
            PG8_WAIT_V(6); PG8_BAR; PG8_MMA(1, 1, At, B1); PG8_BAR;
            }
        }
        if constexpr (ALIGN_EPI) { if (wr == 0) PG8_BAR; }
        O.epi(acc, cur, wr, wc, fr, fq, (const LAS float*)(lds + STAGE_BYTES + (ui & 1) * 1024));
        if (!has_next) break;
        if (!O.keep(cur)) {
#pragma unroll
        for (int a = 0; a < 2; ++a)
#pragma unroll
            for (int b = 0; b < 2; ++b)
#pragma unroll
                for (int m = 0; m < 4; ++m)
#pragma unroll
                    for (int n = 0; n < 2; ++n) acc[a][b][m][n] = (f32x4){0.f, 0.f, 0.f, 0.f};
        }
        cur = nxt; cA = nA; cB = nB; ++ui;
        PG8_BIAS(cur, ui & 1);
        if constexpr (ALIGN_EPI) { if (wr == 1) PG8_BAR; }
    }
    PG8_WAIT_V(0);
    if constexpr (!ALIGN_EPI) { if (wr == 0) PG8_BAR; }
    PG8_BAR;
#undef PG8_BIAS
#undef PG8_SA
#undef PG8_SB
#undef PG8_STAGE
#undef PG8_LDA
#undef PG8_LDB
#undef PG8_MMA
#undef PG8_WAIT_V
#undef PG8_WAIT_L
#undef PG8_BAR
#undef PG8_SCHED
}
}
using pg8::Unit;

template <int WGM = 8>
__device__ __forceinline__ void tile_order(int L, int nM, int nN, int& pm, int& pn) {
    const int nwg = nM * nN; int wgid = L;
    { const int q = nwg / 8, r = nwg % 8, xcd = wgid % 8, off = wgid / 8; wgid = (xcd < r ? xcd * (q + 1) : r * (q + 1) + (xcd - r) * q) + off; }
    const int nig = WGM * nN, gid = wgid / nig, fm = gid * WGM, gsz = (nM - fm) < WGM ? (nM - fm) : WGM;
    pm = fm + ((wgid % nig) % gsz); pn = (wgid % nig) / gsz;
}

struct OpIn {
    static constexpr bool PERM = true, LDS_BIAS = true;
    __device__ __forceinline__ const float* bias_ptr(const Unit& u) const { return (const float*)(ws + WS_BIASP) + u.pn * 256; }
    unsigned char* ws; unsigned lda, ldb, akstep; int nt;
    __device__ __forceinline__ bool get(int ui, int c, int G, Unit& u) const { const int L = ui * G + c; if (L >= 64 * 43) return false; tile_order<4>(L, 64, 43, u.pm, u.pn); u.sub = 0; return true; }
    __device__ __forceinline__ const char* a_ptr(const Unit& u) const { return (const char*)(ws + WS_HB) + (size_t)u.pm * 256 * lda; }
    __device__ __forceinline__ const char* b_ptr(const Unit& u) const { return (const char*)(ws + WS_WTIN) + (size_t)u.pn * 256 * ldb; }
    __device__ __forceinline__ bool keep(const Unit&) const { return false; }
    __device__ __forceinline__ void epi(f32x4 (&acc)[2][2][4][2], const Unit& u, int wr, int wc, int fr, int fq, const LAS float* lb) const {
        const int pn = u.pn;
        const int row0 = u.pm * 256 + wr * 64 + fr;
        const int ct0 = wc * 32 + 8 * fq;
        f32x4 bv[2][2];
#pragma unroll
        for (int bj = 0; bj < 2; ++bj)
#pragma unroll
            for (int n = 0; n < 2; ++n) bv[bj][n] = *(const LAS f32x4*)(lb + ct0 + bj * 128 + 4 * n);
        int mode = 0;
        bf16_t* base = nullptr; int ld = LDPA; int tbase = 0;
        int trows = 256; bool tiled = false;
        if (pn < 4) { mode = 1; base = (bf16_t*)(ws + WS_PA) + PA_Q + pn * 256; }
        else if (pn == 4) { base = (bf16_t*)(ws + WS_PA) + PA_CK; }
        else if (pn == 5) { base = (bf16_t*)(ws + WS_PA) + PA_CV; }
        else if (pn == 6) { mode = 6; base = (bf16_t*)(ws + WS_SKB); }
        else if (pn == 7) { mode = 4; base = (bf16_t*)(ws + WS_SVT); trows = 256; tbase = 0; tiled = true; }
        else if (pn == 8) { mode = 6; base = (bf16_t*)(ws + WS_WKB); }
        else if (pn == 9) { mode = 4; base = (bf16_t*)(ws + WS_WVT); trows = 256; tbase = 0; tiled = true; }
        else if (pn < 14) { mode = 2; base = (bf16_t*)(ws + WS_PA) + PA_ZN + (pn - 10) * 256; }
        else if (pn < 16) { base = (bf16_t*)(ws + WS_PA) + PA_GQ + (pn - 14) * 256; }
        else if (pn < 18) { base = (bf16_t*)(ws + WS_PA) + PA_GK + (pn - 16) * 256; }
        else if (pn < 22) { mode = 4; base = (bf16_t*)(ws + WS_GVT); trows = 1024; tbase = (pn - 18) * 256; }
        else if (pn < 26) { mode = 2; base = (bf16_t*)(ws + WS_PA) + PA_ZG + (pn - 22) * 256; }
        else if (pn < 42) { mode = 3; base = (bf16_t*)(ws + WS_PB) + (pn - 26) * 256; ld = LDPB; }
        else { mode = 5; }
        if (mode <= 3) {
#pragma unroll
            for (int ai = 0; ai < 2; ++ai)
#pragma unroll
                for (int m = 0; m < 4; ++m) { bf16_t* rowp = base + (size_t)(row0 + ai * 128 + m * 16) * ld + ct0;
#pragma unroll
                    for (int bj = 0; bj < 2; ++bj) { f32x4 v0 = acc[ai][bj][m][0] + bv[bj][0], v1 = acc[ai][bj][m][1] + bv[bj][1];
                        if (mode == 1) { v0 = v0 * QSCALE; v1 = v1 * QSCALE; }
                        else if (mode == 2) {
#pragma unroll
                            for (int e = 0; e < 4; ++e) { v0[e] = siluf_(v0[e]); v1[e] = siluf_(v1[e]); } }
                        else if (mode == 3) {
#pragma unroll
                            for (int e = 0; e < 4; ++e) { v0[e] = sigmoidf_(v0[e]); v1[e] = sigmoidf_(v1[e]); } }
                        u32x4 w; w.x = pk2(v0[0], v0[1]); w.y = pk2(v0[2], v0[3]); w.z = pk2(v1[0], v1[1]); w.w = pk2(v1[2], v1[3]);
                        *(u32x4*)(rowp + bj * 128) = w; } }
        } else if (mode == 6) {
#pragma unroll
            for (int ai = 0; ai < 2; ++ai)
#pragma unroll
                for (int m = 0; m < 4; ++m) { const int row = row0 + ai * 128 + m * 16; const int b = row >> 13, t = row & 8191;
#pragma unroll
                    for (int bj = 0; bj < 2; ++bj) { const int c = ct0 + bj * 128; const f32x4 v0 = acc[ai][bj][m][0] + bv[bj][0], v1 = acc[ai][bj][m][1] + bv[bj][1];
                        u32x4 w; w.x = pk2(v0[0], v0[1]); w.y = pk2(v0[2], v0[3]); w.z = pk2(v1[0], v1[1]); w.w = pk2(v1[2], v1[3]);
                        *(u32x4*)(base + ((size_t)((b * 4 + (c >> 6)) * T_ + t)) * 64 + (c & 63)) = w; } }
        } else if (mode == 4) {
#pragma unroll
            for (int ai = 0; ai < 2; ++ai)
#pragma unroll
                for (int m = 0; m < 4; ++m) { const int row = row0 + ai * 128 + m * 16; const int b = row >> 13, t = row & 8191;
                    bf16_t* colp = base + ((size_t)(b * trows + tbase + ct0)) * T_ + t;
#pragma unroll
                    for (int bj = 0; bj < 2; ++bj)
#pragma unroll
                        for (int n = 0; n < 2; ++n) { const f32x4 v = acc[ai][bj][m][n] + bv[bj][n];
#pragma unroll
                            for (int e = 0; e < 4; ++e) { const unsigned p = pk2(v[e], 0.f);
                                if (tiled) { const int c = ct0 + bj * 128 + 4 * n + e;
                                    base[((size_t)(((b * 4 + (c >> 6)) * 128 + (t >> 6)) * 64 + (c & 63))) * 64 + (t & 63)] = (bf16_t)(p & 0xffffu); }
                                else colp[(size_t)(bj * 128 + 4 * n + e) * T_] = (bf16_t)(p & 0xffffu); } } }
        } else {
            if (wc < 2) {
                float* sm = (float*)(ws + WS_SM);
#pragma unroll
                for (int ai = 0; ai < 2; ++ai)
#pragma unroll
                    for (int m = 0; m < 4; ++m) { const int row = row0 + ai * 128 + m * 16;
#pragma unroll
                        for (int n = 0; n < 2; ++n) { f32x4 v = acc[ai][0][m][n] + bv[0][n]; const int c0 = ct0 + 4 * n;
                            if (c0 < 48) {
#pragma unroll
                                for (int e = 0; e < 4; ++e) v[e] = sigmoidf_(v[e]); }
                            *(f32x4*)(sm + (size_t)row * 64 + c0) = v; } }
            }
        }
    }
};

struct OpCmp {
    static constexpr bool PERM = true, LDS_BIAS = true;
    __device__ __forceinline__ const float* bias_ptr(const Unit& u) const { return (const float*)(ws + WS_SSQ) + u.sub * 256; }
    unsigned char* ws; unsigned lda, ldb, akstep; int nt;
    __device__ __forceinline__ bool get(int ui, int c, int G, Unit& u) const { const int L = ui * G + c; if (L >= 32) return false; u.pm = L & 15; u.pn = 0; u.sub = L >> 4; return true; }
    __device__ __forceinline__ const char* a_ptr(const Unit& u) const {
        const int bg = u.pm >> 1, n0 = (u.pm & 1) * 256, b = bg >> 2, g = bg & 3;
        return (const char*)(ws + WS_PA) + ((size_t)(b * T_ + 16 * n0) * LDPA + (u.sub ? PA_CV : PA_CK) + g * 64) * 2; }
    __device__ __forceinline__ const char* b_ptr(const Unit& u) const { return (const char*)(ws + WS_W1T) + (size_t)u.sub * 256 * 2048 * 2; }
    __device__ __forceinline__ bool keep(const Unit&) const { return false; }
    __device__ __forceinline__ void epi(f32x4 (&acc)[2][2][4][2], const Unit& u, int wr, int wc, int fr, int fq, const LAS float* lb) const {
        const int row0 = u.pm * 256 + wr * 64 + fr, ct0 = wc * 32 + 8 * fq;
        bf16_t* hid = (bf16_t*)(ws + WS_HID) + (size_t)u.sub * 4096 * 256;
        f32x4 bv[2][2];
#pragma unroll
        for (int bj = 0; bj < 2; ++bj)
#pragma unroll
            for (int n = 0; n < 2; ++n) bv[bj][n] = *(const LAS f32x4*)(lb + ct0 + bj * 128 + 4 * n);
#pragma unroll
        for (int ai = 0; ai < 2; ++ai)
#pragma unroll
            for (int m = 0; m < 4; ++m) { bf16_t* rowp = hid + (size_t)(row0 + ai * 128 + m * 16) * 256 + ct0;
#pragma unroll
                for (int bj = 0; bj < 2; ++bj) { f32x4 v0 = acc[ai][bj][m][0] + bv[bj][0], v1 = acc[ai][bj][m][1] + bv[bj][1];
#pragma unroll
                    for (int e = 0; e < 4; ++e) { v0[e] = siluf_(v0[e]); v1[e] = siluf_(v1[e]); }
                    u32x4 w; w.x = pk2(v0[0], v0[1]); w.y = pk2(v0[2], v0[3]); w.z = pk2(v1[0], v1[1]); w.w = pk2(v1[2], v1[3]);
                    *(u32x4*)(rowp + bj * 128) = w; } }
    }
};

struct OpMerge {
    static constexpr bool PERM = true, LDS_BIAS = false;
    __device__ __forceinline__ const float* bias_ptr(const Unit&) const { return nullptr; }
    unsigned char* ws; unsigned lda, ldb, akstep; int nt;
    __device__ __forceinline__ bool get(int ui, int c, int G, Unit& u) const { const int L = (ui >> 1) * G + c; if (L >= 64 * 8) return false; tile_order<4>(L, 64, 8, u.pm, u.pn); u.sub = ui & 1; return true; }
    __device__ __forceinline__ const char* a_ptr(const Unit& u) const { return (const char*)(ws + WS_PA) + ((size_t)u.pm * 256 * LDPA + (u.sub ? PA_ZG : PA_Q)) * 2; }
    __device__ __forceinline__ const char* b_ptr(const Unit& u) const { return (const char*)(ws + WS_WTBR) + ((size_t)u.pn * 256 * 2048 + (u.sub ? 1024 : 0)) * 2; }
    __device__ __forceinline__ bool keep(const Unit& u) const { return u.sub == 0; }
    __device__ __forceinline__ void epi(f32x4 (&acc)[2][2][4][2], const Unit& u, int wr, int wc, int fr, int fq, const LAS float* lb) const {
        const int row0 = u.pm * 256 + wr * 64 + fr, col0 = u.pn * 256 + wc * 32 + 8 * fq;
        const bf16_t* pb = (const bf16_t*)(ws + WS_PB);
        bf16_t* mg = (bf16_t*)(ws + WS_HB);
#pragma unroll
        for (int ai = 0; ai < 2; ++ai)
#pragma unroll
            for (int m = 0; m < 4; ++m) { const size_t row = (size_t)(row0 + ai * 128 + m * 16);
#pragma unroll
                for (int bj = 0; bj < 2; ++bj) {
                    const u32x4 s2 = *(const u32x4*)(pb + row * LDPB + 2048 + col0 + bj * 128);
                    if (u.sub == 0) {
                        const u32x4 s1 = *(const u32x4*)(pb + row * LDPB + col0 + bj * 128);
                        f32x4& v0 = acc[ai][bj][m][0]; f32x4& v1 = acc[ai][bj][m][1];
                        v0[0] *= bflo(s1.x) * __builtin_amdgcn_rcpf(bflo(s2.x)); v0[1] *= bfhi(s1.x) * __builtin_amdgcn_rcpf(bfhi(s2.x));
                        v0[2] *= bflo(s1.y) * __builtin_amdgcn_rcpf(bflo(s2.y)); v0[3] *= bfhi(s1.y) * __builtin_amdgcn_rcpf(bfhi(s2.y));
                        v1[0] *= bflo(s1.z) * __builtin_amdgcn_rcpf(bflo(s2.z)); v1[1] *= bfhi(s1.z) * __builtin_amdgcn_rcpf(bfhi(s2.z));
                        v1[2] *= bflo(s1.w) * __builtin_amdgcn_rcpf(bflo(s2.w)); v1[3] *= bfhi(s1.w) * __builtin_amdgcn_rcpf(bfhi(s2.w));
                    } else {
                        const f32x4 v0 = acc[ai][bj][m][0], v1 = acc[ai][bj][m][1];
                        u32x4 w; w.x = pk2(v0[0] * bflo(s2.x), v0[1] * bfhi(s2.x)); w.y = pk2(v0[2] * bflo(s2.y), v0[3] * bfhi(s2.y));
                        w.z = pk2(v1[0] * bflo(s2.z), v1[1] * bfhi(s2.z)); w.w = pk2(v1[2] * bflo(s2.w), v1[3] * bfhi(s2.w));
                        *(u32x4*)(mg + row * 2048 + col0 + bj * 128) = w;
                    } } }
    }
};

struct OpOut {
    static constexpr bool PERM = true, LDS_BIAS = true;
    __device__ __forceinline__ const float* bias_ptr(const Unit& u) const { return (const float*)(ws + WS_GATE) + ((u.pm * 256) >> 13) * 2048 + u.pn * 256; }
    unsigned char* ws; const float* x; float* out; unsigned lda, ldb, akstep; int nt;
    __device__ __forceinline__ bool get(int ui, int c, int G, Unit& u) const { const int L = ui * G + c; if (L >= 64 * 8) return false; tile_order<4>(L, 64, 8, u.pm, u.pn); u.sub = 0; return true; }
    __device__ __forceinline__ const char* a_ptr(const Unit& u) const { return (const char*)(ws + WS_HB) + (size_t)u.pm * 256 * 2048 * 2; }
    __device__ __forceinline__ const char* b_ptr(const Unit& u) const { return (const char*)(ws + WS_WTOUT) + (size_t)u.pn * 256 * 2048 * 2; }
    __device__ __forceinline__ bool keep(const Unit&) const { return false; }
    __device__ __forceinline__ void epi(f32x4 (&acc)[2][2][4][2], const Unit& u, int wr, int wc, int fr, int fq, const LAS float* lb) const {
        const int row0 = u.pm * 256 + wr * 64 + fr, col0 = u.pn * 256 + wc * 32 + 8 * fq;
        bf16_t* dl = (bf16_t*)(ws + WS_PA);
        const int ct0 = wc * 32 + 8 * fq;
        f32x4 gv[2][2];
#pragma unroll
        for (int bj = 0; bj < 2; ++bj)
#pragma unroll
            for (int n = 0; n < 2; ++n) gv[bj][n] = *(const LAS f32x4*)(lb + ct0 + bj * 128 + 4 * n);
#pragma unroll
        for (int ai = 0; ai < 2; ++ai)
#pragma unroll
            for (int m = 0; m < 4; ++m) { bf16_t* rowp = dl + (size_t)(row0 + ai * 128 + m * 16) * 2048 + col0;
#pragma unroll
                for (int bj = 0; bj < 2; ++bj) { const f32x4 v0 = gv[bj][0] * acc[ai][bj][m][0], v1 = gv[bj][1] * acc[ai][bj][m][1];
                    u32x4 w; w.x = pk2(v0[0], v0[1]); w.y = pk2(v0[2], v0[3]); w.z = pk2(v1[0], v1[1]); w.w = pk2(v1[2], v1[3]);
                    *(u32x4*)(rowp + bj * 128) = w; } }
    }
};

__device__ __forceinline__ void tr_item(const float* src, int ldsrc, int k0, int scol, bf16_t* dst, int lddst, int n0, int kd0, LAS float* scr, int lane) {
#pragma unroll 8
    for (int i = 0; i < 32; ++i) { const int kk = 2 * i + (lane >> 5); scr[kk * 33 + (lane & 31)] = scol >= 0 ? src[(size_t)(k0 + kk) * ldsrc + scol] : 0.f; }
    LDS_WAIT();
    const int c = lane & 7;
#pragma unroll
    for (int j = 0; j < 4; ++j) { const int n = (lane >> 3) + 8 * j; const LAS float* s = scr + (8 * c) * 33 + n;
        u32x4 o; o.x = pk2(s[0 * 33], s[1 * 33]); o.y = pk2(s[2 * 33], s[3 * 33]); o.z = pk2(s[4 * 33], s[5 * 33]); o.w = pk2(s[6 * 33], s[7 * 33]);
        *(u32x4*)(dst + (size_t)(n0 + n) * lddst + kd0 + k0 + 8 * c) = o; }
    LDS_WAIT();
}
__device__ __forceinline__ int in_orig_col(int n) {
    if (n < 2560) return n;
    if (n < 5632) return n + 48;
    if (n < 10752) return n + 64;
    if (n < 10800) return 2560 + (n - 10752);
    if (n < 10816) return 5680 + (n - 10800);
    return -1;
}
__device__ __forceinline__ void p0_phase(const Args& a, LAS unsigned char* lds, int G) {
    const int tid = threadIdx.x, lane = tid & 63, wave = tid >> 6;
    unsigned char* ws = a.ws;
    LAS float* scr = (LAS float*)(lds + wave * 16384);
    const int gw = blockIdx.x * 8 + wave, NGW = G * 8;
    constexpr int I_IN = 32 * 344, I_BR = 16 * 64, I_OUT = 32 * 64, I_W1 = 32 * 8, I_W2 = 4 * 2, I_ADA = 16 * 96, I_BIAS = 172, I_CB = 2 * 4 * 8;
    constexpr int NITEMS = I_IN + 2 * I_BR + I_OUT + 2 * I_W1 + 2 * I_W2 + I_ADA + I_BIAS + I_CB;
    for (int it = gw; it < NITEMS; it += NGW) {
        int r = it;
        if (r < I_IN) { const int kb = r / 344, nb = r % 344; tr_item(a.in[5], NREAL, 64 * kb, in_orig_col(32 * nb + (lane & 31)), (bf16_t*)(ws + WS_WTIN), 2048, 32 * nb, 0, scr, lane); continue; } r -= I_IN;
        if (r < I_BR) { const int kb = r / 64, nb = r % 64; tr_item(a.in[16], 2048, 64 * kb, 32 * nb + (lane & 31), (bf16_t*)(ws + WS_WTBR), 2048, 32 * nb, 0, scr, lane); continue; } r -= I_BR;
        if (r < I_BR) { const int kb = r / 64, nb = r % 64; tr_item(a.in[17], 2048, 64 * kb, 32 * nb + (lane & 31), (bf16_t*)(ws + WS_WTBR), 2048, 32 * nb, 1024, scr, lane); continue; } r -= I_BR;
        if (r < I_OUT) { const int kb = r / 64, nb = r % 64; tr_item(a.in[18], 2048, 64 * kb, 32 * nb + (lane & 31), (bf16_t*)(ws + WS_WTOUT), 2048, 32 * nb, 0, scr, lane); continue; } r -= I_OUT;
        if (r < I_W1) { const int kb = r / 8, nb = r % 8; tr_item(a.in[9], 256, 64 * kb, 32 * nb + (lane & 31), (bf16_t*)(ws + WS_W1T), 2048, 32 * nb, 0, scr, lane); continue; } r -= I_W1;
        if (r < I_W1) { const int kb = r / 8, nb = r % 8; tr_item(a.in[11], 256, 64 * kb, 32 * nb + (lane & 31), (bf16_t*)(ws + WS_W1T) + 256 * 2048, 2048, 32 * nb, 0, scr, lane); continue; } r -= I_W1;
        if (r < I_W2) { const int kb = r / 2, nb = r % 2; tr_item(a.in[10], 64, 64 * kb, 32 * nb + (lane & 31), (bf16_t*)(ws + WS_W2T), 256, 32 * nb, 0, scr, lane); continue; } r -= I_W2;
        if (r < I_W2) { const int kb = r / 2, nb = r % 2; tr_item(a.in[12], 64, 64 * kb, 32 * nb + (lane & 31), (bf16_t*)(ws + WS_W2T) + 64 * 256, 256, 32 * nb, 0, scr, lane); continue; } r -= I_W2;
        if (r < I_ADA) {
            const int kc = r / 96, j = (r % 96) * 64 + lane; const float* w = a.in[2] + (size_t)(kc * 128) * 6144 + j; const float* c0 = a.in[1] + kc * 128; const float* c1 = c0 + 2048;
            float s0 = 0.f, s1 = 0.f;
#pragma unroll 8
            for (int k = 0; k < 128; ++k) { const float wv = w[(size_t)k * 6144]; s0 += c0[k] * wv; s1 += c1[k] * wv; }
            float* ap = (float*)(ws + WS_APART) + (size_t)kc * 2 * 6144; ap[j] = s0; ap[6144 + j] = s1; continue; } r -= I_ADA;
        if (r < I_BIAS) { const int n = r * 64 + lane; const int oc = in_orig_col(n); ((float*)(ws + WS_BIASP))[n] = oc >= 0 ? a.in[6][oc] : 0.f; continue; } r -= I_BIAS;
        {
            const int which = r >> 5, jc = (r >> 3) & 3, kc = r & 7, j = jc * 64 + lane;
            const float* pos = a.in[which ? 8 : 7] + kc * 256; const float* w = a.in[which ? 11 : 9] + (size_t)(kc * 256) * 256 + j; float s = 0.f;
#pragma unroll 8
            for (int k = 0; k < 256; ++k) s += pos[k] * w[(size_t)k * 256];
            ((float*)(ws + WS_CB1P))[which * 2048 + kc * 256 + j] = s; }
    }
}

__device__ __forceinline__ void p1_phase(const Args& a, LAS unsigned char* lds, int G) {
    const int tid = threadIdx.x, lane = tid & 63, wave = tid >> 6;
    unsigned char* ws = a.ws;
    const float* ap = (const float*)(ws + WS_APART);
    const float* bada = a.in[3];
    for (int idx = blockIdx.x * 512 + tid; idx < 4096; idx += G * 512) { const int b = idx >> 11, k = idx & 2047; float s = bada[4096 + k];
        for (int kc = 0; kc < 16; ++kc) s += ap[(size_t)kc * 2 * 6144 + b * 6144 + 4096 + k];
        ((float*)(ws + WS_GATE))[idx] = s; }
    for (int idx = blockIdx.x * 512 + tid; idx < 512; idx += G * 512) { const float* cb = (const float*)(ws + WS_CB1P) + (idx >> 8) * 2048 + (idx & 255); float s = 0.f;
        for (int p = 0; p < 8; ++p) s += cb[p * 256];
        ((float*)(ws + WS_SSQ))[idx] = s; }
    LAS float* gsc = (LAS float*)lds; LAS float* sh = gsc + 2048;
    for (int chunk = blockIdx.x; chunk < 256; chunk += G) {
        const int b = chunk >> 7;
        __syncthreads();
        for (int k = tid; k < 2048; k += 512) { float s0 = bada[k], s1 = bada[2048 + k];
            for (int kc = 0; kc < 16; ++kc) { const float* p = ap + (size_t)kc * 2 * 6144 + b * 6144; s0 += p[k]; s1 += p[2048 + k]; }
            sh[k] = s0; gsc[k] = (1.f + s1) * a.in[4][k]; }
        __syncthreads();
        for (int rr = wave; rr < 64; rr += 8) {
            const int row = chunk * 64 + rr;
            const f32x4* xr = (const f32x4*)(a.in[0] + (size_t)row * 2048) + lane;
            f32x4 v[8]; float s = 0.f;
#pragma unroll
            for (int j = 0; j < 8; ++j) { v[j] = xr[64 * j]; s += (v[j][0] * v[j][0] + v[j][1] * v[j][1]) + (v[j][2] * v[j][2] + v[j][3] * v[j][3]); }
            const float rstd = 1.0f / sqrtf(wave_sum(s) * (1.f / 2048.f) + EPS_);
            u32x2* o = (u32x2*)((bf16_t*)(ws + WS_HB) + (size_t)row * 2048) + lane;
#pragma unroll
            for (int j = 0; j < 8; ++j) { const int k = (lane + 64 * j) * 4; const f32x4 g4 = *(const LAS f32x4*)(gsc + k), s4 = *(const LAS f32x4*)(sh + k);
                u32x2 w; w.x = pk2(v[j][0] * rstd * g4[0] + s4[0], v[j][1] * rstd * g4[1] + s4[1]); w.y = pk2(v[j][2] * rstd * g4[2] + s4[2], v[j][3] * rstd * g4[3] + s4[3]);
                o[64 * j] = w; }
        }
    }
}

constexpr int GL_GA = 32768, GL_TOT = 36864, GL_QP = 40960, GL_KP = 57344, GL_AL = 73728, GL_SSQ = 81920;

__device__ __forceinline__ void gla_cumsum(const Args& a, LAS unsigned char* lds, int b, int h, int c, float (&bv)[16], float& blast) {
    const int tid = threadIdx.x, k = tid & 127, ig = tid >> 7;
    const float* sm = (const float*)(a.ws + WS_SM);
    LAS float* GA = (LAS float*)(lds + GL_GA); LAS float* TOT = (LAS float*)(lds + GL_TOT);
    const int tok0 = b * T_ + c * 64;
    __syncthreads();
    { const int idx = tid * 2, i = idx >> 4, r = idx & 15; const f32x2 v = *(const f32x2*)(sm + (size_t)(tok0 + i) * 64 + 48 + r); GA[idx] = v[0]; GA[idx + 1] = v[1]; }
    float wa[16];
#pragma unroll
    for (int r = 0; r < 16; ++r) wa[r] = a.in[13][r * 512 + h * 128 + k];
    const float ba = a.in[14][h * 128 + k];
    __syncthreads();
    float run = 0.f;
#pragma unroll
    for (int e = 0; e < 16; ++e) { const LAS float* g = GA + (16 * ig + e) * 16; float x = ba;
#pragma unroll
        for (int r = 0; r < 16; ++r) x += g[r] * wa[r];
        const float sp = fmaxf(-x, 0.f) + LN2 * __builtin_amdgcn_logf(1.f + ex2(-fabsf(x) * LOG2E));
        run -= sp * 0.0625f; bv[e] = run; }
    TOT[ig * 128 + k] = run;
    __syncthreads();
    float pre = 0.f, tot = 0.f;
#pragma unroll
    for (int g = 0; g < 4; ++g) { const float t = TOT[g * 128 + k]; if (g < ig) pre += t; tot += t; }
#pragma unroll
    for (int e = 0; e < 16; ++e) bv[e] += pre;
    blast = tot;
}

__device__ __forceinline__ size_t us_off(int bh, int c, int v) { return ((size_t)((bh * 32 + (v >> 3)) * 128 + c) * 8 + (v & 7)) * 128; }
__device__ __forceinline__ void gla_pass_a(const Args& a, LAS unsigned char* lds, int item) {
    const int tid = threadIdx.x, lane = tid & 63, wave = tid >> 6, fr = lane & 15, fq = lane >> 4, k = tid & 127, ig = tid >> 7;
    const int bh = item >> 7, c = item & 127, b = bh >> 2, h = bh & 3;
    unsigned char* ws = a.ws;
    float bv[16], blast;
    gla_cumsum(a, lds, b, h, c, bv, blast);
    if (ig == 0) ((float*)(ws + WS_GAM))[(size_t)(bh * 128 + c) * 128 + k] = fexp(blast);
    LAS unsigned char* KT = lds + GL_QP;
    const bf16_t* gk = (const bf16_t*)(ws + WS_PA) + (size_t)(b * T_ + c * 64 + 16 * ig) * LDPA + PA_GK + h * 128 + k;
    {
        float kv[16];
#pragma unroll
        for (int e = 0; e < 16; ++e) kv[e] = bf2f(gk[(size_t)e * LDPA]) * fexp(blast - bv[e]);
        u32x4 w0, w1; w0.x = pk2(kv[0], kv[1]); w0.y = pk2(kv[2], kv[3]); w0.z = pk2(kv[4], kv[5]); w0.w = pk2(kv[6], kv[7]);
        w1.x = pk2(kv[8], kv[9]); w1.y = pk2(kv[10], kv[11]); w1.z = pk2(kv[12], kv[13]); w1.w = pk2(kv[14], kv[15]);
        *(LAS u32x4*)(KT + k * 128 + (((2 * ig) ^ (k & 7)) << 4)) = w0;
        *(LAS u32x4*)(KT + k * 128 + (((2 * ig + 1) ^ (k & 7)) << 4)) = w1;
    }
    __syncthreads();
    const bf16_t* gvt = (const bf16_t*)(ws + WS_GVT) + (size_t)(b * 1024 + h * 256 + 32 * wave) * T_ + c * 64;
    bf16x8 vf[2][2];
#pragma unroll
    for (int vt = 0; vt < 2; ++vt)
#pragma unroll
        for (int js = 0; js < 2; ++js) vf[vt][js] = *(const bf16x8*)(gvt + (size_t)(16 * vt + fr) * T_ + 32 * js + 8 * fq);
    bf16_t* us = (bf16_t*)(ws + WS_HB);
#pragma unroll
    for (int kt = 0; kt < 8; ++kt) {
        const int kr = 16 * kt + fr;
        const bf16x8 k0 = *(const LAS bf16x8*)(KT + kr * 128 + (((fq) ^ (kr & 7)) << 4));
        const bf16x8 k1 = *(const LAS bf16x8*)(KT + kr * 128 + (((4 + fq) ^ (kr & 7)) << 4));
#pragma unroll
        for (int vt = 0; vt < 2; ++vt) { f32x4 acc = (f32x4){0.f, 0.f, 0.f, 0.f};
            acc = __builtin_amdgcn_mfma_f32_16x16x32_bf16(k0, vf[vt][0], acc, 0, 0, 0);
            acc = __builtin_amdgcn_mfma_f32_16x16x32_bf16(k1, vf[vt][1], acc, 0, 0, 0);
            u32x2 w; w.x = pk2(acc[0], acc[1]); w.y = pk2(acc[2], acc[3]);
            *(u32x2*)(us + us_off(bh, c, 32 * wave + 16 * vt + fr) + 16 * kt + 4 * fq) = w; }
    }
}

__device__ __forceinline__ void gla_scan(const Args& a, int G, bool dummy) {
    unsigned char* ws = a.ws;
    for (int blk = blockIdx.x; blk < 256; blk += G) {
        const int bh = blk >> 5, k2 = (threadIdx.x & 63) * 2;
        unsigned* p = (unsigned*)((bf16_t*)(ws + WS_HB) + (size_t)blk * 128 * 1024 + threadIdx.x * 2);
        const f32x2* gm = (const f32x2*)((const float*)(ws + WS_GAM) + (size_t)bh * 128 * 128 + k2);
        float s0 = 0.f, s1 = 0.f;
#pragma unroll 32
        for (int c = 0; c < 128; ++c) { const unsigned u = p[c * 512]; const f32x2 g = gm[c * 64];
            (dummy ? (unsigned*)(ws + WS_WTIN) + (((size_t)blk * 128 * 512 + threadIdx.x) & 0x7fffffu) : p)[c * 512] = pk2(s0, s1); s0 = g[0] * s0 + bflo(u); s1 = g[1] * s1 + bfhi(u); }
    }
}

__device__ __forceinline__ void gla_pass_c(const Args& a, LAS unsigned char* lds, int item, bf16_t* ydst, int ldy) {
    const int tid = threadIdx.x, lane = tid & 63, wave = tid >> 6, fr = lane & 15, fq = lane >> 4, k = tid & 127, ig = tid >> 7;
    const int bh = item >> 7, c = item & 127, b = bh >> 2, h = bh & 3;
    unsigned char* ws = a.ws;
    float bv[16], blast;
    const int tok0 = b * T_ + c * 64;
    bf16_t qraw[16], kraw[16];
    {
        const bf16_t* gq = (const bf16_t*)(ws + WS_PA) + (size_t)(tok0 + 16 * ig) * LDPA + PA_GQ + h * 128 + k;
        const bf16_t* gk = gq + (PA_GK - PA_GQ);
#pragma unroll
        for (int e = 0; e < 16; ++e) { qraw[e] = gq[(size_t)e * LDPA]; kraw[e] = gk[(size_t)e * LDPA]; }
    }
    gla_cumsum(a, lds, b, h, c, bv, blast);
    LAS unsigned char* QP = lds + GL_QP; LAS unsigned char* KP = lds + GL_KP; LAS unsigned char* AL = lds + GL_AL; LAS float* SSQ = (LAS float*)(lds + GL_SSQ);
    {
        const int ck = k >> 3, ko = (k & 7) * 2;
#pragma unroll
        for (int e = 0; e < 16; ++e) { const int i = 16 * ig + e; const int off = i * 256 + ((ck ^ (i & 7)) << 4) + ko;
            const float qv = bf2f(qraw[e]) * fexp(bv[e]) * 0.08838834764831845f;
            const float kv = bf2f(kraw[e]) * fexp(-bv[e]);
            *(LAS bf16_t*)(QP + off) = (bf16_t)(pk2(qv, 0.f) & 0xffffu); *(LAS bf16_t*)(KP + off) = (bf16_t)(pk2(kv, 0.f) & 0xffffu); }
    }
    __syncthreads();
    {
        const int it = wave >> 1;
#pragma unroll
        for (int q = 0; q < 2; ++q) { const int jt = (wave & 1) * 2 + q; f32x4 acc = (f32x4){0.f, 0.f, 0.f, 0.f};
            if (jt <= it) {
                const int jr = 16 * jt + fr, ir = 16 * it + fr;
#pragma unroll
                for (int ks = 0; ks < 4; ++ks) {
                    const bf16x8 kf = *(const LAS bf16x8*)(KP + jr * 256 + (((4 * ks + fq) ^ (jr & 7)) << 4));
                    const bf16x8 qf = *(const LAS bf16x8*)(QP + ir * 256 + (((4 * ks + fq) ^ (ir & 7)) << 4));
                    acc = __builtin_amdgcn_mfma_f32_16x16x32_bf16(kf, qf, acc, 0, 0, 0); }
            }
            const int i = 16 * it + fr, j0 = 16 * jt + 4 * fq;
#pragma unroll
            for (int jj = 0; jj < 4; ++jj) if (j0 + jj > i) acc[jj] = 0.f;
            u32x2 w; w.x = pk2(acc[0], acc[1]); w.y = pk2(acc[2], acc[3]);
            *(LAS u32x2*)(AL + i * 128 + ((((j0 >> 3)) ^ (i & 7)) << 4) + (fq & 1) * 8) = w; }
    }
    __syncthreads();
    f32x4 o[2][4];
#pragma unroll
    for (int vt = 0; vt < 2; ++vt)
#pragma unroll
        for (int it = 0; it < 4; ++it) o[vt][it] = (f32x4){0.f, 0.f, 0.f, 0.f};
    {
        const bf16_t* gvt = (const bf16_t*)(ws + WS_GVT) + (size_t)(b * 1024 + h * 256 + 32 * wave) * T_ + c * 64;
#pragma unroll
        for (int js = 0; js < 2; ++js) {
            bf16x8 vf[2];
#pragma unroll
            for (int vt = 0; vt < 2; ++vt) vf[vt] = *(const bf16x8*)(gvt + (size_t)(16 * vt + fr) * T_ + 32 * js + 8 * fq);
#pragma unroll
            for (int it = 0; it < 4; ++it) { const int ir = 16 * it + fr;
                const bf16x8 af = *(const LAS bf16x8*)(AL + ir * 128 + (((4 * js + fq) ^ (ir & 7)) << 4));
#pragma unroll
                for (int vt = 0; vt < 2; ++vt) o[vt][it] = __builtin_amdgcn_mfma_f32_16x16x32_bf16(vf[vt], af, o[vt][it], 0, 0, 0); }
        }
        const bf16_t* st = (const bf16_t*)(ws + WS_HB);
#pragma unroll
        for (int ks = 0; ks < 4; ++ks) {
            bf16x8 sf[2];
#pragma unroll
            for (int vt = 0; vt < 2; ++vt) sf[vt] = *(const bf16x8*)(st + us_off(bh, c, 32 * wave + 16 * vt + fr) + 32 * ks + 8 * fq);
#pragma unroll
            for (int it = 0; it < 4; ++it) { const int ir = 16 * it + fr;
                const bf16x8 qf = *(const LAS bf16x8*)(QP + ir * 256 + (((4 * ks + fq) ^ (ir & 7)) << 4));
#pragma unroll
                for (int vt = 0; vt < 2; ++vt) o[vt][it] = __builtin_amdgcn_mfma_f32_16x16x32_bf16(sf[vt], qf, o[vt][it], 0, 0, 0); }
        }
    }
#pragma unroll
    for (int it = 0; it < 4; ++it) { float s = 0.f;
#pragma unroll
        for (int vt = 0; vt < 2; ++vt) s += (o[vt][it][0] * o[vt][it][0] + o[vt][it][1] * o[vt][it][1]) + (o[vt][it][2] * o[vt][it][2] + o[vt][it][3] * o[vt][it][3]);
        s += __shfl_xor(s, 16); s += __shfl_xor(s, 32);
        if (fq == 0) SSQ[wave * 64 + 16 * it + fr] = s; }
    __syncthreads();
    const float* gn = a.in[15];
#pragma unroll
    for (int it = 0; it < 4; ++it) { const int i = 16 * it + fr; float tot = 0.f;
#pragma unroll
        for (int w = 0; w < 8; ++w) tot += SSQ[w * 64 + i];
        const float rstd = 1.0f / sqrtf(tot * (1.f / 256.f) + EPS_);
        bf16_t* zrow = (bf16_t*)(ws + WS_PA) + (size_t)(tok0 + i) * LDPA + PA_ZG + h * 256 + 32 * wave;
#pragma unroll
        for (int vt = 0; vt < 2; ++vt) { const int v0 = 16 * vt + 4 * fq; const u32x2 z = *(const u32x2*)(zrow + v0); const f32x4 g = *(const f32x4*)(gn + 32 * wave + v0);
            u32x2 w; w.x = pk2(o[vt][it][0] * rstd * g[0] * bflo(z.x), o[vt][it][1] * rstd * g[1] * bfhi(z.x));
            w.y = pk2(o[vt][it][2] * rstd * g[2] * bflo(z.y), o[vt][it][3] * rstd * g[3] * bfhi(z.y));
            *(u32x2*)(ydst + (size_t)(tok0 + i) * ldy + h * 256 + 32 * wave + v0) = w; } }
}

__device__ __forceinline__ void cmp2_item(const Args& a, int item, int lane) {
    const int fr = lane & 15, fq = lane >> 4; unsigned char* ws = a.ws;
    const int which = item >> 8, rt = item & 255;
    const bf16_t* hid = (const bf16_t*)(ws + WS_HID) + ((size_t)which * 4096 + rt * 16) * 256;
    const bf16_t* w2t = (const bf16_t*)(ws + WS_W2T) + (size_t)which * 64 * 256;
    f32x4 acc[4];
#pragma unroll
    for (int dt = 0; dt < 4; ++dt) acc[dt] = (f32x4){0.f, 0.f, 0.f, 0.f};
#pragma unroll
    for (int ks = 0; ks < 8; ++ks) {
        const bf16x8 hf = *(const bf16x8*)(hid + (size_t)fr * 256 + 32 * ks + 8 * fq);
#pragma unroll
        for (int dt = 0; dt < 4; ++dt) { const bf16x8 wf = *(const bf16x8*)(w2t + (size_t)(16 * dt + fr) * 256 + 32 * ks + 8 * fq);
            if (which == 0) acc[dt] = __builtin_amdgcn_mfma_f32_16x16x32_bf16(wf, hf, acc[dt], 0, 0, 0);
            else acc[dt] = __builtin_amdgcn_mfma_f32_16x16x32_bf16(hf, wf, acc[dt], 0, 0, 0); }
    }
    const int row = rt * 16, bg = row >> 9, n0 = row & 511;
#pragma unroll
    for (int dt = 0; dt < 4; ++dt) { u32x2 w; w.x = pk2(acc[dt][0], acc[dt][1]); w.y = pk2(acc[dt][2], acc[dt][3]);
        if (which == 0) *(u32x2*)((bf16_t*)(ws + WS_KC) + ((size_t)bg * 512 + n0 + fr) * 64 + 16 * dt + 4 * fq) = w;
        else { const int n = n0 + 4 * fq; *(u32x2*)((bf16_t*)(ws + WS_VCT) + ((size_t)((bg * 8 + (n >> 6)) * 64 + 16 * dt + fr)) * 64 + (n & 63)) = w; } }
}

constexpr int NS_IMP = 32768, NS_SELM = 65536, NS_UNI = 66560, NS_LIST = 66624, NS_NL = 66752, NS_OUTS = 67584;
constexpr float NEG_INF = -__builtin_inff();

struct TileSrc { const char* k; const char* v; size_t ks, vs; };
__device__ __forceinline__ void tile_load(const TileSrc& s, int tid, u32x4& kr, u32x4& vr) {
    const int row = tid >> 3, ch = tid & 7;
    kr = *(const u32x4*)(s.k + (size_t)row * s.ks + ch * 16); vr = *(const u32x4*)(s.v + (size_t)row * s.vs + ch * 16);
}
__device__ __forceinline__ int swz_k(int row) { return ((row >> 3) & 3) | (((row >> 1) & 1) << 2); }
__device__ __forceinline__ int swz_v(int row) { return (row >> 1) & 7; }
__device__ __forceinline__ void tile_store(LAS unsigned char* buf, int tid, const u32x4& kr, const u32x4& vr) {
    const int row = tid >> 3, ch = tid & 7;
    *(LAS u32x4*)(buf + row * 128 + ((ch ^ swz_k(row)) << 4)) = kr; *(LAS u32x4*)(buf + 8192 + row * 128 + ((ch ^ swz_v(row)) << 4)) = vr;
}
__device__ __forceinline__ void qk_tile(LAS const unsigned char* kb, const bf16x8 (&qf)[2][2], f32x4 (&s)[2][2][2], int fr, int fq) {
#pragma unroll
    for (int kk = 0; kk < 2; ++kk)
#pragma unroll
        for (int aa = 0; aa < 2; ++aa) { const int kr = 32 * kk + 8 * (fr >> 2) + 4 * aa + (fr & 3);
            const bf16x8 k0 = *(const LAS bf16x8*)(kb + kr * 128 + (((fq) ^ swz_k(kr)) << 4));
            const bf16x8 k1 = *(const LAS bf16x8*)(kb + kr * 128 + (((4 + fq) ^ swz_k(kr)) << 4));
#pragma unroll
            for (int h = 0; h < 2; ++h) { s[h][kk][aa] = __builtin_amdgcn_mfma_f32_16x16x32_bf16(k0, qf[h][0], s[h][kk][aa], 0, 0, 0);
                s[h][kk][aa] = __builtin_amdgcn_mfma_f32_16x16x32_bf16(k1, qf[h][1], s[h][kk][aa], 0, 0, 0); } }
}
__device__ __forceinline__ void bias_tile(f32x4 (&s)[2][2][2], float d1, float pstride, float win, bool mask, const float (&slope2)[2], const float (&cm)[2]) {
    if (mask) {
#pragma unroll
        for (int kk = 0; kk < 2; ++kk)
#pragma unroll
            for (int aa = 0; aa < 2; ++aa)
#pragma unroll
                for (int j = 0; j < 4; ++j) { const float rel = d1 + pstride * (float)(32 * kk + 4 * aa + j);
                    const bool valid = (rel <= 0.f) && (rel > -win);
                    s[0][kk][aa][j] = valid ? __builtin_fmaf(slope2[0], rel, cm[0]) : NEG_INF; s[1][kk][aa][j] = valid ? __builtin_fmaf(slope2[1], rel, cm[1]) : NEG_INF; }
    } else {
#pragma unroll
        for (int kk = 0; kk < 2; ++kk)
#pragma unroll
            for (int aa = 0; aa < 2; ++aa)
#pragma unroll
                for (int j = 0; j < 4; ++j) { const float rel = d1 + pstride * (float)(32 * kk + 4 * aa + j);
                    s[0][kk][aa][j] = __builtin_fmaf(slope2[0], rel, cm[0]); s[1][kk][aa][j] = __builtin_fmaf(slope2[1], rel, cm[1]); }
    }
}
__device__ __forceinline__ void pv_tile(LAS const unsigned char* vb, const f32x4 (&p)[2][2][2], f32x4 (&O)[2][4], int fr, int fq) {
#pragma unroll
    for (int kk = 0; kk < 2; ++kk) {
        bf16x8 pf[2];
#pragma unroll
        for (int h = 0; h < 2; ++h) { u32x4 w; w.x = pk2(p[h][kk][0][0], p[h][kk][0][1]); w.y = pk2(p[h][kk][0][2], p[h][kk][0][3]); w.z = pk2(p[h][kk][1][0], p[h][kk][1][1]); w.w = pk2(p[h][kk][1][2], p[h][kk][1][3]); pf[h] = as_bf16x8(w); }
#pragma unroll
        for (int dt = 0; dt < 4; ++dt) { const int dr = 16 * dt + fr;
            const bf16x8 vf = *(const LAS bf16x8*)(vb + dr * 128 + (((4 * kk + fq) ^ swz_v(dr)) << 4));
#pragma unroll
            for (int h = 0; h < 2; ++h) O[h][dt] = __builtin_amdgcn_mfma_f32_16x16x32_bf16(vf, pf[h], O[h][dt], 0, 0, 0); }
    }
}
constexpr float SM_THR = 5.0f;
__device__ __forceinline__ void softmax_tile(f32x4 (&s)[2][2][2], float (&m)[2], float (&l)[2], f32x4 (&O)[2][4], bool scaleO, LAS const unsigned char* vb, int fr, int fq) {
    float mx[2]; bool need = false;
#pragma unroll
    for (int h = 0; h < 2; ++h) {
        float v = NEG_INF;
#pragma unroll
        for (int kk = 0; kk < 2; ++kk)
#pragma unroll
            for (int aa = 0; aa < 2; ++aa) v = fmaxf(v, fmaxf(fmaxf(s[h][kk][aa][0], s[h][kk][aa][1]), fmaxf(s[h][kk][aa][2], s[h][kk][aa][3])));
        mx[h] = v; need = need || ((m[h] == NEG_INF) ? (v > NEG_INF) : (v > SM_THR));
    }
    const unsigned long long needm = __ballot(need);
    if ((needm | __ballot((mx[0] > -150.f) || (mx[1] > -150.f))) != 0ull) {
    if (needm != 0ull) {
#pragma unroll
        for (int h = 0; h < 2; ++h) {
            float q = mx[h]; q = fmaxf(q, __shfl_xor(q, 16)); q = fmaxf(q, __shfl_xor(q, 32));
            const bool unset = (m[h] == NEG_INF);
            const float delta = unset ? ((q == NEG_INF) ? 0.f : q) : fmaxf(q, 0.f);
            const float al = unset ? 1.f : ex2(-delta);
            m[h] = unset ? q : m[h] + delta;
            l[h] *= al;
            if (scaleO) {
#pragma unroll
                for (int dt = 0; dt < 4; ++dt) O[h][dt] = O[h][dt] * al; }
#pragma unroll
            for (int kk = 0; kk < 2; ++kk)
#pragma unroll
                for (int aa = 0; aa < 2; ++aa) s[h][kk][aa] = s[h][kk][aa] - delta;
        }
    }
#pragma unroll
    for (int h = 0; h < 2; ++h) { float ls = 0.f;
#pragma unroll
        for (int kk = 0; kk < 2; ++kk)
#pragma unroll
            for (int aa = 0; aa < 2; ++aa)
#pragma unroll
                for (int j = 0; j < 4; ++j) { const float p = ex2(s[h][kk][aa][j]); s[h][kk][aa][j] = p; ls += p; }
        l[h] += ls; }
    if (vb) pv_tile(vb, s, O, fr, fq);
    }
}
__device__ __forceinline__ void set_cm(float (&cm)[2], const float (&m)[2], float selbase) {
#pragma unroll
    for (int h = 0; h < 2; ++h) cm[h] = selbase - ((m[h] == NEG_INF) ? 0.f : m[h]);
}

#define TILE_PIPE(N, SRC, BODY) do { const int _n = (N); u32x4 _k0, _v0, _k1, _v1; \
    { TileSrc _s; SRC(0, _s); tile_load(_s, tid, _k0, _v0); tile_store(lds, tid, _k0, _v0); } \
    if (_n > 1) { TileSrc _s; SRC(1, _s); tile_load(_s, tid, _k1, _v1); } \
    __syncthreads(); \
    for (int _i = 0; _i < _n; _i += 2) { \
        if (_i + 2 < _n) { TileSrc _s; SRC(_i + 2, _s); tile_load(_s, tid, _k0, _v0); } \
        BODY(_i, lds); \
        if (_i + 1 < _n) tile_store(lds + 16384, tid, _k1, _v1); \
        __syncthreads(); \
        if (_i + 1 >= _n) break; \
        if (_i + 3 < _n) { TileSrc _s; SRC(_i + 3, _s); tile_load(_s, tid, _k1, _v1); } \
        BODY(_i + 1, lds + 16384); \
        if (_i + 2 < _n) tile_store(lds, tid, _k0, _v0); \
        __syncthreads(); \
    } } while (0)

__device__ __forceinline__ void nsa_item(const Args& a, LAS unsigned char* lds, int item, bf16_t* ydst, int ldy) {
    const int tid = threadIdx.x, lane = tid & 63, wave = __builtin_amdgcn_readfirstlane(tid >> 6), fr = lane & 15, fq = lane >> 4;
    unsigned char* ws = a.ws;
    const int qt = 127 - (item >> 3), bg = item & 7, b = bg >> 2, g = bg & 3;
    const int t0 = qt * 64, cur = qt;
    const int qs = wave >> 1, hp = wave & 1, head0 = g * 4 + 2 * hp;
    const int tqi = t0 + 16 * qs + fr; const float tq = (float)tqi;
    const size_t tok = (size_t)b * T_ + tqi;
    const bf16_t* PA = (const bf16_t*)(ws + WS_PA);
    bf16x8 qf[2][2];
#pragma unroll
    for (int h = 0; h < 2; ++h)
#pragma unroll
        for (int ks = 0; ks < 2; ++ks) qf[h][ks] = *(const bf16x8*)(PA + tok * LDPA + PA_Q + (head0 + h) * 64 + 32 * ks + 8 * fq);
    float slope2[2];
#pragma unroll
    for (int h = 0; h < 2; ++h) slope2[h] = ex2(-0.5f * (float)(head0 + h + 1)) * LOG2E;
    const float* smrow = (const float*)(ws + WS_SM) + tok * 64;
    LAS float* IMP = (LAS float*)(lds + NS_IMP);
    LAS unsigned* SELM = (LAS unsigned*)(lds + NS_SELM); LAS unsigned* UNI = (LAS unsigned*)(lds + NS_UNI);
    LAS unsigned char* LIST = lds + NS_LIST; LAS int* NL = (LAS int*)(lds + NS_NL);
    const float BIGW = 1e30f;

    LAS f32x4* OUTS = (LAS f32x4*)(lds + NS_OUTS + wave * 8192) + lane;
    f32x4 O[2][4]; float m[2], l[2];
    __syncthreads();
    if (tid < 4) UNI[tid] = 0u;

    const int ncmp = 4 * qt + 3, nct = (ncmp + 63) >> 6;
    TileSrc cs; cs.k = (const char*)(ws + WS_KC) + (size_t)bg * 512 * 128; cs.v = (const char*)(ws + WS_VCT) + (size_t)bg * 8 * 8192; cs.ks = 128; cs.vs = 128;
    m[0] = m[1] = NEG_INF; l[0] = l[1] = 0.f;
#define CMP_SRC(i, d) do { d = cs; d.k += (size_t)(i) * 8192; d.v += (size_t)(i) * 8192; } while (0)
#define CMP1_SRC(i, d) do { d = cs; d.k += (size_t)(nct - 1 - (i)) * 8192; d.v += (size_t)(nct - 1 - (i)) * 8192; } while (0)
#define CMP1_BODY(ii, buf) do { const int i = nct - 1 - (ii);     \
        f32x4 s[2][2][2]; float cm[2]; set_cm(cm, m, 0.f); \
        bias_tile(s, (float)(1024 * i + 31 + 128 * fq) - tq, 16.f, BIGW, 1024 * i + 1039 > t0, slope2, cm); \
        qk_tile(buf, qf, s, fr, fq); \
        softmax_tile(s, m, l, O, false, (LAS const unsigned char*)0, fr, fq); } while (0)
    TILE_PIPE(nct, CMP1_SRC, CMP1_BODY);
#undef CMP1_BODY
#undef CMP1_SRC
    float mu[2], il[2];
#pragma unroll
    for (int h = 0; h < 2; ++h) { float lt = l[h]; lt += __shfl_xor(lt, 16); lt += __shfl_xor(lt, 32); mu[h] = (m[h] == NEG_INF) ? 0.f : m[h]; il[h] = lt > 0.f ? 1.0f / lt : 0.f; }
    float gcmp[2];
#pragma unroll
    for (int h = 0; h < 2; ++h)
#pragma unroll
        for (int dt = 0; dt < 4; ++dt) O[h][dt] = (f32x4){0.f, 0.f, 0.f, 0.f};
    {
        float prev7 = 0.f;
        LAS float* imp = (hp == 0 ? IMP : (LAS float*)(lds + NS_OUTS)) + (16 * qs + fr) * 128;
        gcmp[0] = smrow[(head0 + 0) * 3 + 0]; gcmp[1] = smrow[(head0 + 1) * 3 + 0];
#define CMP2_BODY(ii, buf) do { const int i = (ii); \
            f32x4 s[2][2][2]; float cm[2]; cm[0] = -mu[0]; cm[1] = -mu[1]; \
            bias_tile(s, (float)(1024 * i + 31 + 128 * fq) - tq, 16.f, BIGW, 1024 * i + 1039 > t0, slope2, cm); \
            qk_tile(buf, qf, s, fr, fq); \
            _Pragma("unroll") for (int h = 0; h < 2; ++h) _Pragma("unroll") for (int kk = 0; kk < 2; ++kk) _Pragma("unroll") for (int aa = 0; aa < 2; ++aa) _Pragma("unroll") for (int j = 0; j < 4; ++j) s[h][kk][aa][j] = ex2(s[h][kk][aa][j]) * il[h]; \
            _Pragma("unroll") for (int kk = 0; kk < 2; ++kk) { \
                float ph[8]; \
                _Pragma("unroll") for (int aa = 0; aa < 2; ++aa) _Pragma("unroll") for (int j = 0; j < 4; ++j) ph[4 * aa + j] = s[0][kk][aa][j] + s[1][kk][aa][j]; \
                const float cin = __shfl((fq == 3) ? prev7 : ph[7], (lane + 48) & 63);     \
                prev7 = ph[7]; \
                f32x2 w; w[0] = 2.f * (ph[0] + ph[1] + ph[2]) + ph[3] + cin; w[1] = 2.f * (ph[4] + ph[5] + ph[6]) + ph[7] + ph[3]; \
                *(LAS f32x2*)(imp + 16 * i + 8 * kk + 2 * fq) = w; \
            } \
            pv_tile(buf + 8192, s, O, fr, fq); } while (0)
        TILE_PIPE(nct, CMP_SRC, CMP2_BODY);
#undef CMP2_BODY
#undef CMP_SRC
    }
    __syncthreads();
#define GSUM8(v) do { v += __builtin_amdgcn_mov_dpp(v, 0xB1, 0xF, 0xF, true); v += __builtin_amdgcn_mov_dpp(v, 0x4E, 0xF, 0xF, true); v += __builtin_amdgcn_mov_dpp(v, 0x141, 0xF, 0xF, true); } while (0)
    {
        const int kg = lane & 7, qq = wave * 8 + (lane >> 3), j0 = kg * 16;
        unsigned key[16];
        {
            const LAS f32x4* src = (const LAS f32x4*)(IMP + qq * 128 + j0); const LAS f32x4* src2 = (const LAS f32x4*)((LAS float*)(lds + NS_OUTS) + qq * 128 + j0);
#pragma unroll
            for (int v4 = 0; v4 < 4; ++v4) { const f32x4 f = src[v4] + src2[v4];
#pragma unroll
                for (int e = 0; e < 4; ++e) { const int j = j0 + 4 * v4 + e; const bool va = j <= cur, fo = (j == 0) || (j == cur) || (j == cur - 1);
                    key[4 * v4 + e] = va ? (fo ? 0x7f800001u : __float_as_uint(f[e]) + 1u) : 0u; } }
        }
        unsigned mask16 = 0u;
        if (cur < 16) {
#pragma unroll
            for (int i = 0; i < 16; ++i) mask16 |= (key[i] != 0u ? 1u : 0u) << i;
        } else {
            unsigned T = 0u; bool done;
            { int cnz = 0;
#pragma unroll
              for (int i = 0; i < 16; ++i) cnz += (key[i] > 1u) ? 1 : 0;
              GSUM8(cnz); done = cnz < 16; if (done) T = 1u; }
#pragma unroll 1
            for (int bit = 30; bit >= 0; --bit) {
                if (__ballot(!done) == 0ull) break;
                const unsigned cand = T | (1u << bit); int c = 0;
#pragma unroll
                for (int i = 0; i < 16; ++i) c += (key[i] >= cand) ? 1 : 0;
                GSUM8(c);
                if (c >= 16 && !done) { T = cand; done = (c == 16); } }
            int gtc = 0, eqc = 0;
#pragma unroll
            for (int i = 0; i < 16; ++i) { gtc += (key[i] > T) ? 1 : 0; eqc += (key[i] == T) ? 1 : 0; }
            GSUM8(gtc);
            const int need = 16 - gtc;
            int incl = eqc;
            { int t = __builtin_amdgcn_mov_dpp(incl, 0x111, 0xF, 0xF, true); if (kg >= 1) incl += t; t = __builtin_amdgcn_mov_dpp(incl, 0x112, 0xF, 0xF, true); if (kg >= 2) incl += t;
              t = __builtin_amdgcn_mov_dpp(incl, 0x114, 0xF, 0xF, true); if (kg >= 4) incl += t; }
            int rank = incl - eqc;
#pragma unroll
            for (int i = 0; i < 16; ++i) { const bool eq = key[i] == T; const bool sel = (key[i] > T) || (eq && rank < need); rank += eq ? 1 : 0; mask16 |= (sel ? 1u : 0u) << i; }
        }
        ((LAS unsigned short*)SELM)[qq * 8 + kg] = (unsigned short)mask16;
        unsigned um = mask16; um |= (unsigned)__shfl_xor((int)um, 8); um |= (unsigned)__shfl_xor((int)um, 16); um |= (unsigned)__shfl_xor((int)um, 32);
        if (lane < 8) ((LAS unsigned short*)(lds + 66816))[wave * 8 + kg] = (unsigned short)um;
    }
#undef GSUM8
    __syncthreads();
    {
        float gc[2];
#pragma unroll
        for (int h = 0; h < 2; ++h) gc[h] = gcmp[h];
#pragma unroll
        for (int h = 0; h < 2; ++h)
#pragma unroll
            for (int dt = 0; dt < 4; ++dt) OUTS[(4 * h + dt) * 64] = O[h][dt] * gc[h];
    }
    if (tid < 64) {
        unsigned w0 = 0u, w1 = 0u, w2 = 0u, w3 = 0u;
#pragma unroll
        for (int w = 0; w < 8; ++w) { const LAS unsigned* uw = (const LAS unsigned*)(lds + 66816) + w * 4; w0 |= uw[0]; w1 |= uw[1]; w2 |= uw[2]; w3 |= uw[3]; }
        const int j0 = lane, j1 = lane + 64;
        const bool in0 = ((j0 < 32 ? w0 >> j0 : w1 >> (j0 - 32)) & 1u) != 0, in1 = ((j0 < 32 ? w2 >> j0 : w3 >> (j0 - 32)) & 1u) != 0;
        const unsigned long long b0 = __ballot(in0), b1 = __ballot(in1);
        const unsigned long long below = (lane == 0) ? 0ull : (~0ull >> (64 - lane));
        const int c0 = __popcll(b0);
        if (in0) LIST[__popcll(b0 & below)] = (unsigned char)j0;
        if (in1) LIST[c0 + __popcll(b1 & below)] = (unsigned char)j1;
        if (lane == 0) *NL = c0 + __popcll(b1);
    }
    __syncthreads();
    {
        const int nl = *NL;
        const unsigned sm0 = SELM[(16 * qs + fr) * 4 + 0], sm1 = SELM[(16 * qs + fr) * 4 + 1], sm2 = SELM[(16 * qs + fr) * 4 + 2], sm3 = SELM[(16 * qs + fr) * 4 + 3];
        m[0] = m[1] = NEG_INF; l[0] = l[1] = 0.f;
#pragma unroll
        for (int h = 0; h < 2; ++h)
#pragma unroll
            for (int dt = 0; dt < 4; ++dt) O[h][dt] = (f32x4){0.f, 0.f, 0.f, 0.f};
        TileSrc ss; ss.k = (const char*)(ws + WS_SKB) + (size_t)(b * 4 + g) * 128 * 8192; ss.v = (const char*)(ws + WS_SVT) + (size_t)(b * 4 + g) * 128 * 8192; ss.ks = 128; ss.vs = 128;
        float gslc[2]; gslc[0] = smrow[(head0 + 0) * 3 + 1]; gslc[1] = smrow[(head0 + 1) * 3 + 1];
#define SLC_SRC(i, d) do { const int jn = LIST[nl - 1 - (i)]; d = ss; d.k += (size_t)jn * 8192; d.v += (size_t)jn * 8192; } while (0)
#define SLC_BODY(ii, buf) do { const int j = LIST[nl - 1 - (ii)]; \
            const unsigned wsel = (j < 32) ? sm0 : (j < 64) ? sm1 : (j < 96) ? sm2 : sm3; \
            const bool sel = ((wsel >> (j & 31)) & 1u) != 0; \
            if (__ballot(sel) != 0ull) { \
                f32x4 s[2][2][2]; float cm[2]; set_cm(cm, m, sel ? 0.f : NEG_INF); \
                bias_tile(s, (float)(64 * j + 8 * fq) - tq, 1.f, BIGW, j == cur, slope2, cm); \
                qk_tile(buf, qf, s, fr, fq); \
                softmax_tile(s, m, l, O, true, buf + 8192, fr, fq); \
            } } while (0)
        TILE_PIPE(nl, SLC_SRC, SLC_BODY);
#undef SLC_BODY
#undef SLC_SRC
#pragma unroll
        for (int h = 0; h < 2; ++h) { float lt = l[h]; lt += __shfl_xor(lt, 16); lt += __shfl_xor(lt, 32);
            const float sc = (lt > 0.f ? 1.0f / lt : 0.f) * gslc[h];
#pragma unroll
            for (int dt = 0; dt < 4; ++dt) OUTS[(4 * h + dt) * 64] = OUTS[(4 * h + dt) * 64] + O[h][dt] * sc; }
    }
    u32x2 zz[2][4];
    {
        m[0] = m[1] = NEG_INF; l[0] = l[1] = 0.f;
#pragma unroll
        for (int h = 0; h < 2; ++h)
#pragma unroll
            for (int dt = 0; dt < 4; ++dt) O[h][dt] = (f32x4){0.f, 0.f, 0.f, 0.f};
        TileSrc ss; ss.k = (const char*)(ws + WS_WKB) + (size_t)(b * 4 + g) * 128 * 8192; ss.v = (const char*)(ws + WS_WVT) + (size_t)(b * 4 + g) * 128 * 8192; ss.ks = 128; ss.vs = 128;
        const int kt0 = (t0 >= 512) ? 0 : (512 - t0) >> 6;
        float gwin[2]; gwin[0] = smrow[(head0 + 0) * 3 + 2]; gwin[1] = smrow[(head0 + 1) * 3 + 2];
#pragma unroll
        for (int h = 0; h < 2; ++h)
#pragma unroll
            for (int dt = 0; dt < 4; ++dt) zz[h][dt] = *(const u32x2*)(PA + tok * LDPA + PA_ZN + (head0 + h) * 64 + 16 * dt + 4 * fq);
#define WIN_SRC(i, d) do { const int jt = qt - 8 + (8 - (i)); d = ss; d.k += (size_t)jt * 8192; d.v += (size_t)jt * 8192; } while (0)
#define WIN_BODY(ii, buf) do { const int kt = 8 - (ii); \
            f32x4 s[2][2][2]; float cm[2]; set_cm(cm, m, 0.f); \
            bias_tile(s, (float)(t0 - 512 + 64 * kt + 8 * fq) - tq, 1.f, 512.f, kt == 0 || kt == 8, slope2, cm); \
            qk_tile(buf, qf, s, fr, fq); \
            softmax_tile(s, m, l, O, true, buf + 8192, fr, fq); } while (0)
        TILE_PIPE(9 - kt0, WIN_SRC, WIN_BODY);
#undef WIN_BODY
#undef WIN_SRC
#pragma unroll
        for (int h = 0; h < 2; ++h) { float lt = l[h]; lt += __shfl_xor(lt, 16); lt += __shfl_xor(lt, 32);
            const float sc = (lt > 0.f ? 1.0f / lt : 0.f) * gwin[h];
#pragma unroll
            for (int dt = 0; dt < 4; ++dt) O[h][dt] = OUTS[(4 * h + dt) * 64] + O[h][dt] * sc; }
    }
#pragma unroll
    for (int h = 0; h < 2; ++h)
#pragma unroll
        for (int dt = 0; dt < 4; ++dt) { const int col = (head0 + h) * 64 + 16 * dt + 4 * fq;
            const u32x2 z = zz[h][dt];
            u32x2 w; w.x = pk2(O[h][dt][0] * bflo(z.x), O[h][dt][1] * bfhi(z.x)); w.y = pk2(O[h][dt][2] * bflo(z.y), O[h][dt][3] * bfhi(z.y));
            *(u32x2*)(ydst + tok * ldy + col) = w; }
}

__device__ __forceinline__ void final_norm(const Args& a, int G, float* dst) {
    const int tid = threadIdx.x, lane = tid & 63, wave = tid >> 6;
    const float* fg = a.in[19]; const bf16_t* dl = (const bf16_t*)(a.ws + WS_PA);
    for (int row = blockIdx.x * 8 + wave; row < NTOK; row += G * 8) {
        const f32x4* xr = (const f32x4*)(a.in[0] + (size_t)row * 2048) + lane; const u32x2* dr = (const u32x2*)(dl + (size_t)row * 2048) + lane;
        f32x4 v[8]; float s = 0.f;
#pragma unroll
        for (int j = 0; j < 8; ++j) { const f32x4 xv = xr[64 * j]; const u32x2 d = dr[64 * j];
            v[j] = (f32x4){xv[0] + bflo(d.x), xv[1] + bfhi(d.x), xv[2] + bflo(d.y), xv[3] + bfhi(d.y)};
            s += (v[j][0] * v[j][0] + v[j][1] * v[j][1]) + (v[j][2] * v[j][2] + v[j][3] * v[j][3]); }
        const float rstd = 1.0f / sqrtf(wave_sum(s) * (1.f / 2048.f) + EPS_);
        f32x4* d = (f32x4*)(dst + (size_t)row * 2048) + lane;
#pragma unroll
        for (int j = 0; j < 8; ++j) { const f32x4 g = *((const f32x4*)fg + lane + 64 * j); d[64 * j] = v[j] * rstd * g; }
    }
}

#define XB_TMO      128
#define XB_XCNT(j)  (256  + 64 * (j))
#define XB_XSUB(j)  (1280 + 64 * (j))
#define XB_XGEN(j)  (2304 + 64 * (j))
#define XB_TOP      3328
#define XB_TOPGEN   3392
#define XCD_BAR_WORDS 3456
#define XB_SPIN_CAP (1u << 18)
__device__ __forceinline__ unsigned xb_ld(unsigned* p)              { return __hip_atomic_load(p, __ATOMIC_RELAXED, __HIP_MEMORY_SCOPE_AGENT); }
__device__ __forceinline__ unsigned xb_add(unsigned* p, unsigned v) { return __hip_atomic_fetch_add(p, v, __ATOMIC_RELAXED, __HIP_MEMORY_SCOPE_AGENT); }
__device__ __forceinline__ unsigned xb_xcc_id() { return (unsigned)__builtin_amdgcn_s_getreg((3 << 11) | 20) & 0xFu; }
#define XB_SPIN(cond, bar) do { unsigned _sp = 0; while (cond) { __builtin_amdgcn_s_sleep(1); \
    if ((++_sp & 255u) == 0u) { if (xb_ld(&(bar)[XB_TMO])) break; if (_sp > XB_SPIN_CAP) { atomicAdd(&(bar)[XB_TMO], 1u); break; } } } } while (0)
__device__ __forceinline__ void xcd_barrier_complete(unsigned* bar, unsigned x, unsigned& nloc, unsigned& nx) {
    const unsigned G = gridDim.x;
    unsigned sum, cnt, mine, sp = 0u;
    for (;;) {
        sum = 0u; cnt = 0u; mine = 0u;
#pragma unroll
        for (unsigned j = 0; j < 16; ++j) { const unsigned c = xb_ld(&bar[XB_XCNT(j)]); sum += c; cnt += (c > 0u) ? 1u : 0u; mine = (j == x) ? c : mine; }
        if (sum == G) break;
        __builtin_amdgcn_s_sleep(1);
        if ((++sp & 255u) == 0u) { if (xb_ld(&bar[XB_TMO])) break; if (sp > XB_SPIN_CAP) { atomicAdd(&bar[XB_TMO], 1u); break; } }
    }
    nloc = mine > 0u ? mine : 1u; nx = cnt > 0u ? cnt : 1u;
}
__device__ __forceinline__ void xcd_barrier(unsigned* bar, volatile LAS unsigned* st) {
    asm volatile("s_waitcnt vmcnt(0)" ::: "memory");
    __syncthreads();
    if (threadIdx.x == 0) {
        const unsigned x = xb_xcc_id();
        __builtin_amdgcn_s_waitcnt(0);
        unsigned nloc = st[0], nx = st[1];
        if (nloc == 0u) { xcd_barrier_complete(bar, x, nloc, nx); st[0] = nloc; st[1] = nx; }
        const unsigned old = xb_add(&bar[XB_XSUB(x)], 1u);
        const unsigned gen = old / nloc;
        if (old + 1u == (gen + 1u) * nloc) {
            __builtin_amdgcn_fence(__ATOMIC_RELEASE, "agent");
            asm volatile("s_waitcnt vmcnt(0)" ::: "memory");
            const unsigned og = xb_add(&bar[XB_TOP], 1u);
            const unsigned tg = og / nx;
            if (og + 1u == (tg + 1u) * nx) xb_add(&bar[XB_TOPGEN], 1u);
            else XB_SPIN(xb_ld(&bar[XB_TOPGEN]) == tg, bar);
            __builtin_amdgcn_fence(__ATOMIC_ACQUIRE, "agent");
            xb_add(&bar[XB_XGEN(x)], 1u);
            asm volatile("s_waitcnt vmcnt(0)" ::: "memory");
        } else {
            XB_SPIN(xb_ld(&bar[XB_XGEN(x)]) == gen, bar);
            __builtin_amdgcn_fence(__ATOMIC_ACQUIRE, "agent");
            asm volatile("s_waitcnt vmcnt(0)" ::: "memory");
        }
    }
    __syncthreads();
}

typedef const __attribute__((address_space(4))) Args* KArgPtr;
__device__ __forceinline__ Args load_args() {
    Args r{};
#if defined(__HIP_DEVICE_COMPILE__)
    KArgPtr p = (KArgPtr)__builtin_amdgcn_kernarg_segment_ptr(); asm volatile("" : "+s"(p));
#pragma unroll
    for (int i = 0; i < 20; ++i) r.in[i] = p->in[i];
    r.out = p->out; r.ws = p->ws; r.ph_lo = p->ph_lo; r.ph_hi = p->ph_hi;
#endif
    return r;
}
__global__ void __launch_bounds__(512, 2) mk_fwd(Args ka) {
    extern __shared__ __attribute__((aligned(16))) unsigned char lds_raw[];
    LAS unsigned char* lds = (LAS unsigned char*)lds_raw;
    cg::grid_group grid = cg::this_grid();
    const int lo = ka.ph_lo, hi = ka.ph_hi, G = gridDim.x, bid = blockIdx.x;
    const int tid = threadIdx.x, lane = tid & 63, wave = tid >> 6;
#ifndef PH_MASK
#define PH_MASK 0x1ff
#endif
#define IN(k) (((PH_MASK >> (k)) & 1) && lo <= (k) && (k) < hi)
#if MK_CG_SYNC
#define SEAM(k) do { if (IN(k) && IN((k) + 1)) grid.sync(); } while (0)
#else
#define SEAM(k) do { if (IN(k) && IN((k) + 1)) xcd_barrier((unsigned*)(ka.ws + WS_CTL), (volatile LAS unsigned*)(lds + LDS_XB)); } while (0)
    if (hi - lo > 1) {
        if (tid == 0) { ((volatile LAS unsigned*)(lds + LDS_XB))[0] = 0u; ((volatile LAS unsigned*)(lds + LDS_XB))[1] = 0u; (void)xb_add((unsigned*)(ka.ws + WS_CTL) + XB_XCNT(xb_xcc_id()), 1u); }
        __syncthreads();
    }
    if (lo > 1000) grid.sync();
#endif
    if (IN(0)) { const Args a = load_args(); p0_phase(a, lds, G);
#if PROBE_DUP & 1
        __syncthreads(); p0_phase(a, lds, G);
#endif
    }
    SEAM(0);
    if (IN(1)) { const Args a = load_args(); p1_phase(a, lds, G);
#if PROBE_DUP & 2
        __syncthreads(); p1_phase(a, lds, G);
#endif
    }
    SEAM(1);
    if (IN(2)) { const Args a = load_args(); OpIn op; op.ws = a.ws; op.lda = 4096; op.ldb = 4096; op.akstep = 128; op.nt = 32; pg8::gemm_phase<OpIn, true>(lds, op, G, bid);
#if PROBE_DUP & 4
        pg8::gemm_phase<OpIn, true>(lds, op, G, bid);
#endif
    }
    SEAM(2);
    if (IN(3)) {
        const Args a = load_args();
        { OpCmp op; op.ws = a.ws; op.lda = 16 * LDPA * 2; op.ldb = 4096; op.akstep = LDPA * 2; op.nt = 32; pg8::gemm_phase<OpCmp, true>(lds, op, G, bid); }
        const int first = (G > 64) ? ((bid >= 32) ? bid - 32 : bid + G - 32) : bid;
#if MK_ONE_LAUNCH
        {
            unsigned* qa = (unsigned*)(a.ws + WS_CTL) + 3600 + 128; volatile LAS unsigned* slot = (volatile LAS unsigned*)(lds + LDS_XB + 8);
            for (;;) { __syncthreads(); if (tid == 0) *slot = __hip_atomic_fetch_add(qa, 1u, __ATOMIC_RELAXED, __HIP_MEMORY_SCOPE_AGENT); __syncthreads();
                const int it = (int)*slot; if (it >= 1024) break; gla_pass_a(a, lds, it); }
        }
#else
        for (int it = first; it < 1024; it += G) gla_pass_a(a, lds, it);
#endif
#if PROBE_DUP & 8
        __syncthreads();
        { OpCmp op; op.ws = a.ws; op.lda = 16 * LDPA * 2; op.ldb = 4096; op.akstep = LDPA * 2; op.nt = 32; pg8::gemm_phase<OpCmp, true>(lds, op, G, bid); }
        for (int it = first; it < 1024; it += G) gla_pass_a(a, lds, it);
#endif
    }
    SEAM(3);
    if (IN(4)) {
        const Args a = load_args();
        for (int it = bid * 8 + wave; it < 512; it += G * 8) cmp2_item(a, it, lane);
#if PROBE_DUP & 16
        for (int it = bid * 8 + wave; it < 512; it += G * 8) cmp2_item(a, it, lane);
        gla_scan(a, G, true);
#endif
        gla_scan(a, G, false);
    }
    SEAM(4);
    if (IN(5)) {
        const Args a = load_args();
#ifndef PROBE_DUP_P5
#define PROBE_DUP_P5 0
#endif
#if MK_ONE_LAUNCH
        {
            unsigned* qn = (unsigned*)(a.ws + WS_CTL) + 3600; unsigned* qg = qn + 64;
            volatile LAS unsigned* slot = (volatile LAS unsigned*)(lds + LDS_XB + 8);
            for (;;) { __syncthreads(); if (tid == 0) *slot = __hip_atomic_fetch_add(qn, 1u, __ATOMIC_RELAXED, __HIP_MEMORY_SCOPE_AGENT); __syncthreads();
                const int it = (int)*slot; if (it >= 1024) break; nsa_item(a, lds, it, (bf16_t*)(a.ws + WS_PA) + PA_Q, LDPA); }
            for (;;) { __syncthreads(); if (tid == 0) *slot = __hip_atomic_fetch_add(qg, 1u, __ATOMIC_RELAXED, __HIP_MEMORY_SCOPE_AGENT); __syncthreads();
                const int it = (int)*slot; if (it >= 1024) break; gla_pass_c(a, lds, it, (bf16_t*)(a.ws + WS_PA) + PA_ZG, LDPA); }
        }
#else
        for (int r = 0; r * G < 1024; ++r) { const int it = r * G + ((r & 1) ? G - 1 - bid : bid); if (it < 1024) nsa_item(a, lds, it, (bf16_t*)(a.ws + WS_PA) + PA_Q, LDPA); }
        for (int it = bid; it < 1024; it += G) gla_pass_c(a, lds, it, (bf16_t*)(a.ws + WS_PA) + PA_ZG, LDPA);
#endif
        __syncthreads();
    }
    SEAM(5);
    if (IN(6)) { const Args a = load_args(); OpMerge op; op.ws = a.ws; op.lda = LDPA * 2; op.ldb = 4096; op.akstep = 128; op.nt = 16; pg8::gemm_phase<OpMerge, true>(lds, op, G, bid);
#if PROBE_DUP & 64
        pg8::gemm_phase<OpMerge, true>(lds, op, G, bid);
#endif
    }
    SEAM(6);
    if (IN(7)) { const Args a = load_args(); OpOut op; op.ws = a.ws; op.x = a.in[0]; op.out = a.out; op.lda = 4096; op.ldb = 4096; op.akstep = 128; op.nt = 32; pg8::gemm_phase<OpOut, true>(lds, op, G, bid);
#if PROBE_DUP & 128
        pg8::gemm_phase<OpOut, true>(lds, op, G, bid);
#endif
    }
    SEAM(7);
#ifdef PROBE_SYNC
    if (IN(7) && IN(8)) { for (int i = 0; i < PROBE_SYNC; ++i) xcd_barrier((unsigned*)(ka.ws + WS_CTL), (volatile LAS unsigned*)(lds + LDS_XB)); }
#endif
    if (IN(8)) { const Args a = load_args();
#if PROBE_DUP & 256
        final_norm(a, G, (float*)(a.ws + WS_PA));
#endif
        final_norm(a, G, a.out); }
#ifdef DBG
    if (lo == 9) {
        const Args a = load_args(); unsigned char* ws = a.ws;
        for (size_t i = (size_t)bid * 512 + tid; i < (size_t)NTOK * DM; i += (size_t)G * 512) {
            float v = 0.f;
#if DBG == 1
            v += bf2f(((const bf16_t*)(ws + WS_PA))[i % ((size_t)NTOK * LDPA)]) + bf2f(((const bf16_t*)(ws + WS_PA))[(i + 33554432) % ((size_t)NTOK * LDPA)]) + bf2f(((const bf16_t*)(ws + WS_PA))[(i + 50331648) % ((size_t)NTOK * LDPA)]);
            v += bf2f(((const bf16_t*)(ws + WS_PB))[i]) + bf2f(((const bf16_t*)(ws + WS_PB))[i + 33554432]);
            v += ((const float*)(ws + WS_SM))[i % (16384 * 64)];
            v += bf2f(((const bf16_t*)(ws + WS_SVT))[i % (2 * 256 * 8192)]) + bf2f(((const bf16_t*)(ws + WS_WVT))[i % (2 * 256 * 8192)]) + bf2f(((const bf16_t*)(ws + WS_GVT))[i % (2 * 1024 * 8192)]);
#elif DBG == 2
            v += bf2f(((const bf16_t*)(ws + WS_KC))[i % (8 * 512 * 64)]) + bf2f(((const bf16_t*)(ws + WS_VCT))[i % (8 * 512 * 64)]) + bf2f(((const bf16_t*)(ws + WS_HB))[i]) + ((const float*)(ws + WS_GAM))[i % (8 * 128 * 128)];
#elif DBG == 5
            v += bf2f(((const bf16_t*)(ws + WS_KC))[i % (8 * 512 * 64)]) + bf2f(((const bf16_t*)(ws + WS_VCT))[i % (8 * 512 * 64)]) + bf2f(((const bf16_t*)(ws + WS_HID))[i % (2 * 4096 * 256)]);
#elif DBG == 6 || DBG == 7
            v += bf2f(((const bf16_t*)(ws + WS_HB))[i]) + ((const float*)(ws + WS_GAM))[i % (8 * 128 * 128)];
#elif DBG == 8
            v += ((const float*)(ws + WS_GAM))[i % (8 * 128 * 128)];
#elif DBG == 3
            v += bf2f(((const bf16_t*)(ws + WS_PA))[(i / 2048) * LDPA + (i % 2048 < 1024 ? i % 1024 : 4096 + i % 1024)]);
#elif DBG == 4
            v += bf2f(((const bf16_t*)(ws + WS_HB))[i]);
#endif
            a.out[i] = v;
        }
    }
#endif
}

extern "C" void kernel_launch(void* const* d_in, const int* in_sizes, int n_in, void* d_out, int out_size, void* d_ws, size_t ws_size, hipStream_t stream) {
    static int grid = 0;
    if (grid == 0) {
        if (n_in != 20 || out_size != NTOK * DM || ws_size < WS_END) { fprintf(stderr, "kernel_launch: unexpected problem (n_in %d out %d ws %zu need %zu)\n", n_in, out_size, ws_size, (size_t)WS_END); grid = -1; return; }
        int dev = 0, cus = 0, per_cu = 0;
        hipGetDevice(&dev); hipDeviceGetAttribute(&cus, hipDeviceAttributeMultiprocessorCount, dev);
        if (hipFuncSetAttribute((const void*)mk_fwd, hipFuncAttributeMaxDynamicSharedMemorySize, LDS_BYTES) != hipSuccess) { fprintf(stderr, "kernel_launch: hipFuncSetAttribute failed\n"); grid = -1; return; }
        if (hipOccupancyMaxActiveBlocksPerMultiprocessor(&per_cu, (const void*)mk_fwd, 512, LDS_BYTES) != hipSuccess || per_cu < 1) { fprintf(stderr, "kernel_launch: occupancy query failed (%d)\n", per_cu); per_cu = 1; }
        (void)hipGetLastError();
        grid = cus * per_cu;
        fprintf(stderr, "kernel_launch: grid %d (cus %d x %d)\n", grid, cus, per_cu);
    }
    if (grid < 0) return;
    Args a{};
    for (int i = 0; i < 20; ++i) a.in[i] = (const float*)d_in[i];
    a.out = (float*)d_out; a.ws = (unsigned char*)d_ws;
#if MK_ONE_LAUNCH
    a.ph_lo = 0; a.ph_hi = 9;
    if (hipMemsetAsync((char*)d_ws + WS_CTL, 0, 16384, stream) != hipSuccess) { fprintf(stderr, "kernel_launch: memset of the barrier words failed\n"); return; }
    void* args[] = {&a};
    hipError_t e = hipLaunchCooperativeKernel((const void*)mk_fwd, dim3(grid), dim3(512), args, LDS_BYTES, stream);
    if (e != hipSuccess) fprintf(stderr, "cooperative launch failed: %s (grid %d)\n", hipGetErrorString(e), grid);
#else
#ifdef DBG
    const int plast = (DBG == 7 || DBG == 8) ? 4 : (DBG == 1) ? 3 : (DBG == 2 || DBG == 5 || DBG == 6) ? 5 : (DBG == 3) ? 6 : 7;
    for (int p = 0; p < plast; ++p) { a.ph_lo = p; a.ph_hi = p + 1; hipLaunchKernelGGL(mk_fwd, dim3(grid), dim3(512), LDS_BYTES, stream, a); }
    a.ph_lo = 9; a.ph_hi = 10; hipLaunchKernelGGL(mk_fwd, dim3(grid), dim3(512), LDS_BYTES, stream, a);
#else
    for (int p = 0; p < 9; ++p) { a.ph_lo = p; a.ph_hi = p + 1; hipLaunchKernelGGL(mk_fwd, dim3(grid), dim3(512), LDS_BYTES, stream, a); }
#endif
#endif
}
```

```cpp
#include <hip/hip_runtime.h>
#include <hip/hip_cooperative_groups.h>
#include <cstdio>
#include <cstdint>
namespace cg = cooperative_groups;

#ifndef PROBE_DUP
#define PROBE_DUP 0
#endif
#ifndef MK_CG_SYNC
#define MK_CG_SYNC 0
#endif
#ifndef MK_ONE_LAUNCH
#define MK_ONE_LAUNCH 1
#endif

#define LAS __attribute__((address_space(3)))
typedef unsigned short bf16_t;
typedef short bf16x8 __attribute__((ext_vector_type(8)));
typedef float f32x4 __attribute__((ext_vector_type(4)));
typedef float f32x2 __attribute__((ext_vector_type(2)));
typedef unsigned u32x4 __attribute__((ext_vector_type(4)));
typedef unsigned u32x2 __attribute__((ext_vector_type(2)));

constexpr int T_ = 8192, DM = 2048, NTOK = 16384;
constexpr int NP = 11008, NREAL = 10816;
constexpr int LDPA = 5120, LDPB = 4096;
constexpr int PA_Q = 0, PA_CK = 1024, PA_CV = 1280, PA_SK = 1536, PA_WK = 1792, PA_ZN = 2048, PA_GQ = 3072, PA_GK = 3584, PA_ZG = 4096;
constexpr float LOG2E = 1.4426950408889634f, LN2 = 0.6931471805599453f;
constexpr float QSCALE = 0.125f * LOG2E;
constexpr float EPS_ = 1e-6f;
constexpr int LDS_BYTES = 133376;
constexpr int LDS_XB = 133120;

constexpr size_t al256(size_t x) { return (x + 255) & ~(size_t)255; }
constexpr size_t WS_CTL = 0;
constexpr size_t WS_APART = 16384;
constexpr size_t WS_GATE = WS_APART + al256(32ull * 2 * 6144 * 4);
constexpr size_t WS_BIASP = WS_GATE + al256(2ull * 2048 * 4);
constexpr size_t WS_CB1P = WS_BIASP + al256(11008ull * 4);
constexpr size_t WS_GAM = WS_CB1P + al256(2ull * 8 * 256 * 4);
constexpr size_t WS_SSQ = WS_GAM + al256(8ull * 128 * 128 * 4);
constexpr size_t WS_W2T = WS_SSQ + al256(16384ull * 32 * 4);
constexpr size_t WS_KC = WS_W2T + al256(2ull * 64 * 256 * 2);
constexpr size_t WS_VCT = WS_KC + al256(8ull * 512 * 64 * 2);
constexpr size_t WS_HID = WS_VCT + al256(8ull * 64 * 512 * 2);
constexpr size_t WS_W1T = WS_HID + al256(2ull * 4096 * 256 * 2);
constexpr size_t WS_WTBR = WS_W1T + al256(2ull * 256 * 2048 * 2);
constexpr size_t WS_WTOUT = WS_WTBR + al256(2048ull * 2048 * 2);
constexpr size_t WS_WTIN = WS_WTOUT + al256(2048ull * 2048 * 2);
constexpr size_t WS_SM = WS_WTIN + al256(11008ull * 2048 * 2);
constexpr size_t WS_SVT = WS_SM + al256(16384ull * 64 * 4);
constexpr size_t WS_WVT = WS_SVT + al256(2ull * 256 * 8192 * 2);
constexpr size_t WS_GVT = WS_WVT + al256(2ull * 256 * 8192 * 2);
constexpr size_t WS_HB = WS_GVT + al256(2ull * 1024 * 8192 * 2);
constexpr size_t WS_PA = WS_HB + al256(16384ull * 2048 * 2);
constexpr size_t WS_PB = WS_PA + al256(16384ull * 5120 * 2);
constexpr size_t WS_SKB = WS_PB + al256(16384ull * 4096 * 2);
constexpr size_t WS_WKB = WS_SKB + al256(2ull * 4 * 8192 * 64 * 2);
constexpr size_t WS_END = WS_WKB + al256(2ull * 4 * 8192 * 64 * 2);
static_assert(WS_END <= 512ull * 1024 * 1024, "workspace");

struct Args { const float* in[20]; float* out; unsigned char* ws; int ph_lo, ph_hi; };

typedef __bf16 bf16x2_t __attribute__((ext_vector_type(2)));
__device__ __forceinline__ unsigned pk2(float lo, float hi) { f32x2 v = {lo, hi}; bf16x2_t b = __builtin_convertvector(v, bf16x2_t); return __builtin_bit_cast(unsigned, b); }
__device__ __forceinline__ float bf2f(unsigned short v) { return __uint_as_float(((unsigned)v) << 16); }
__device__ __forceinline__ float bflo(unsigned v) { return __uint_as_float(v << 16); }
__device__ __forceinline__ float bfhi(unsigned v) { return __uint_as_float(v & 0xffff0000u); }
__device__ __forceinline__ float ex2(float x) { return __builtin_amdgcn_exp2f(x); }
__device__ __forceinline__ float fexp(float x) { return __builtin_amdgcn_exp2f(x * LOG2E); }
__device__ __forceinline__ float sigmoidf_(float x) { return __builtin_amdgcn_rcpf(1.f + fexp(-x)); }
__device__ __forceinline__ float siluf_(float x) { return x * sigmoidf_(x); }
__device__ __forceinline__ float wave_sum(float v) {
#pragma unroll
    for (int o = 1; o < 64; o <<= 1) v += __shfl_xor(v, o);
    return v;
}
#define LDS_WAIT() asm volatile("s_waitcnt lgkmcnt(0)" ::: "memory")
__device__ __forceinline__ bf16x8 as_bf16x8(u32x4 v) { union { u32x4 u; bf16x8 b; } x; x.u = v; return x.b; }

namespace pg8 {
constexpr int BM = 256, BK = 64, HALF = 128, HTB = HALF * BK * 2, STAGE_BYTES = 8 * HTB;
__device__ __forceinline__ int lds_byte(int r, int c) { const int st = (r >> 4) * 2 + (c >> 5), rr = r & 15, cc = c & 31, ob = rr * 64 + cc * 2; return st * 1024 + (ob ^ (((ob >> 9) & 1) << 5)); }
__device__ __forceinline__ void stage_rc(int b, int& R, int& C) { const int st = b / 1024, sb = b % 1024, swz = sb ^ (((sb >> 9) & 1) << 5); R = (st >> 1) * 16 + swz / 64; C = (st & 1) * 32 + (swz % 64) / 2; }
__device__ __forceinline__ int perm32(int rho) { const int n = rho >> 4, i = rho & 15; return 8 * (i >> 2) + 4 * n + (i & 3); }
struct Unit { int pm, pn, sub; };

template <class Op, bool SP2, bool ALIGN_EPI = true>
__device__ __forceinline__ void gemm_phase(LAS unsigned char* lds, const Op& O, const int G, const int c) {
    const int tid = threadIdx.x, wid = __builtin_amdgcn_readfirstlane(tid >> 6), lane = tid & 63, wr = wid >> 2, wc = wid & 3, fr = lane & 15, fq = lane >> 4;
    const int nt = O.nt;
    Unit cur, nxt; int ui = 0;
    if (!O.get(0, c, G, cur)) return;
    unsigned voffA[2], voffB[2];
#pragma unroll
    for (int i = 0; i < 2; ++i) { const int bb = tid * 16 + i * 8192; const int R = bb >> 7; const int C = ((((bb >> 4) & 7) ^ ((R >> 1) & 7)) << 3); const int Rb = Op::PERM ? ((R & ~31) + perm32(R & 31)) : R;
        voffA[i] = (unsigned)R * O.lda + (unsigned)C * 2u; voffB[i] = (unsigned)Rb * O.ldb + (unsigned)C * 2u; }
    const size_t kstepA = (size_t)O.akstep, kstepB = (size_t)(BK * 2);
    const size_t hstepA = (size_t)HALF * O.lda, hstepB = (size_t)HALF * O.ldb;
    const unsigned ldsw = (unsigned)wid * 1024u;
    int aoffk[2], boffk[2];
#pragma unroll
    for (int k = 0; k < 2; ++k) { const int pc = ((k * 4 + fq) ^ ((fr >> 1) & 7)) << 4; aoffk[k] = (wr * 64 + fr) * 128 + pc; boffk[k] = (wc * 32 + fr) * 128 + pc; }
#define PG8_SA(b, h) (((b) * 2 + (h)) * HTB)
#define PG8_SB(b, h) ((4 + (b) * 2 + (h)) * HTB)
#define PG8_STAGE(bufoff, gbase, voff) do { _Pragma("unroll") for (int _i = 0; _i < 2; ++_i) \
        __builtin_amdgcn_global_load_lds((const unsigned*)((const char*)(gbase) + (voff)[_i]), (LAS unsigned*)(lds + (bufoff) + ldsw + _i * 8192), 16, 0, 0); } while (0)
#define PG8_LDA(dst, b, h) do { _Pragma("unroll") for (int m = 0; m < 4; ++m) _Pragma("unroll") for (int k = 0; k < 2; ++k) dst[m][k] = *(const LAS bf16x8*)(lds + PG8_SA(b, h) + aoffk[k] + m * 2048); } while (0)
#define PG8_LDB(dst, b, h) do { _Pragma("unroll") for (int n = 0; n < 2; ++n) _Pragma("unroll") for (int k = 0; k < 2; ++k) dst[n][k] = *(const LAS bf16x8*)(lds + PG8_SB(b, h) + boffk[k] + n * 2048); } while (0)
#define PG8_MMA(ai, bj, At, Bt) do { __builtin_amdgcn_s_setprio(1); _Pragma("unroll") for (int m = 0; m < 4; ++m) _Pragma("unroll") for (int n = 0; n < 2; ++n) _Pragma("unroll") for (int k = 0; k < 2; ++k) \
        acc[ai][bj][m][n] = __builtin_amdgcn_mfma_f32_16x16x32_bf16(Bt[n][k], At[m][k], acc[ai][bj][m][n], 0, 0, 0); __builtin_amdgcn_s_setprio(0); } while (0)
#define PG8_WAIT_V(n) asm volatile("s_waitcnt vmcnt(" #n ")" ::: "memory")
#define PG8_WAIT_L(n) asm volatile("s_waitcnt lgkmcnt(" #n ")" ::: "memory")
#define PG8_BAR __builtin_amdgcn_s_barrier()
#define PG8_SCHED __builtin_amdgcn_sched_barrier(0)
    f32x4 acc[2][2][4][2];
#pragma unroll
    for (int a = 0; a < 2; ++a)
#pragma unroll
        for (int b = 0; b < 2; ++b)
#pragma unroll
            for (int m = 0; m < 4; ++m)
#pragma unroll
                for (int n = 0; n < 2; ++n) acc[a][b][m][n] = (f32x4){0.f, 0.f, 0.f, 0.f};
    bf16x8 At[4][2], B0[2][2], B1[2][2];
    const char* cA = O.a_ptr(cur); const char* cB = O.b_ptr(cur);
#define PG8_BIAS(u, slot) do { if constexpr (Op::LDS_BIAS) { if (wid < 4) __builtin_amdgcn_global_load_lds((const unsigned*)(O.bias_ptr(u) + wid * 64 + lane), (LAS unsigned*)(lds + STAGE_BYTES + (slot) * 1024 + wid * 256), 4, 0, 0); } } while (0)
    PG8_BIAS(cur, 0);
    if constexpr (SP2) {
        PG8_STAGE(PG8_SB(0, 0), cB, voffB); PG8_STAGE(PG8_SB(0, 1), cB + hstepB, voffB); PG8_STAGE(PG8_SA(0, 0), cA, voffA); PG8_STAGE(PG8_SA(0, 1), cA + hstepA, voffA);
        if (wr == 1) PG8_BAR;
        PG8_WAIT_V(2); PG8_BAR;
        PG8_STAGE(PG8_SB(1, 0), cB + kstepB, voffB); PG8_STAGE(PG8_SA(1, 0), cA + kstepA, voffA); PG8_STAGE(PG8_SB(1, 1), cB + hstepB + kstepB, voffB);
        PG8_WAIT_V(6); PG8_BAR;
    } else {
        PG8_STAGE(PG8_SB(0, 0), cB, voffB); PG8_STAGE(PG8_SA(0, 0), cA, voffA); PG8_STAGE(PG8_SB(0, 1), cB + hstepB, voffB); PG8_STAGE(PG8_SA(0, 1), cA + hstepA, voffA);
        if (wr == 1) PG8_BAR;
        PG8_WAIT_V(4); PG8_BAR;
        PG8_STAGE(PG8_SB(1, 0), cB + kstepB, voffB); PG8_STAGE(PG8_SA(1, 0), cA + kstepA, voffA); PG8_STAGE(PG8_SB(1, 1), cB + hstepB + kstepB, voffB);
        PG8_WAIT_V(6); PG8_BAR;
    }
    for (;;) {
        const bool has_next = O.get(ui + 1, c, G, nxt);
        const char* nA = has_next ? O.a_ptr(nxt) : cA; const char* nB = has_next ? O.b_ptr(nxt) : cB;
        for (int t = 0; t < nt; t += 2) {
            const bool last = (t == nt - 2);
            const char* a1 = cA + (size_t)(t + 1) * kstepA;
            const char* a2 = last ? nA : cA + (size_t)(t + 2) * kstepA; const char* b2 = last ? nB : cB + (size_t)(t + 2) * kstepB;
            const char* a3 = a2 + kstepA; const char* b3 = b2 + kstepB;
            if constexpr (SP2) {
            PG8_LDB(B0, 0, 0); PG8_LDB(B1, 0, 1); PG8_SCHED; PG8_LDA(At, 0, 0); PG8_STAGE(PG8_SA(1, 1), a1 + hstepA, voffA);
            PG8_WAIT_V(8); PG8_WAIT_L(0); PG8_BAR; PG8_MMA(0, 0, At, B0); PG8_MMA(0, 1, At, B1); PG8_BAR; PG8_SCHED;
            PG8_LDA(At, 0, 1); PG8_STAGE(PG8_SB(0, 0), b2, voffB); PG8_STAGE(PG8_SB(0, 1), b2 + hstepB, voffB); PG8_STAGE(PG8_SA(0, 0), a2, voffA);
            PG8_WAIT_V(8); PG8_WAIT_L(0); PG8_BAR; PG8_MMA(1, 0, At, B0); PG8_MMA(1, 1, At, B1); PG8_BAR; PG8_SCHED;
            PG8_LDB(B0, 1, 0); PG8_LDB(B1, 1, 1); PG8_SCHED; PG8_LDA(At, 1, 0); PG8_STAGE(PG8_SA(0, 1), a2 + hstepA, voffA);
            PG8_WAIT_V(8); PG8_WAIT_L(0); PG8_BAR; PG8_MMA(0, 0, At, B0); PG8_MMA(0, 1, At, B1); PG8_BAR; PG8_SCHED;
            PG8_LDA(At, 1, 1); PG8_STAGE(PG8_SB(1, 0), b3, voffB); PG8_STAGE(PG8_SB(1, 1), b3 + hstepB, voffB); PG8_STAGE(PG8_SA(1, 0), a3, voffA);
            PG8_WAIT_V(8); PG8_WAIT_L(0); PG8_BAR; PG8_MMA(1, 0, At, B0); PG8_MMA(1, 1, At, B1); PG8_BAR; PG8_SCHED;
            } else {
            PG8_LDB(B0, 0, 0); PG8_SCHED; PG8_LDA(At, 0, 0); PG8_STAGE(PG8_SA(1, 1), a1 + hstepA, voffA);
            PG8_WAIT_L(8); PG8_BAR; PG8_WAIT_L(0); PG8_MMA(0, 0, At, B0); PG8_BAR; PG8_SCHED;
            PG8_LDB(B1, 0, 1); PG8_STAGE(PG8_SB(0, 0), b2, voffB);
            PG8_BAR; PG8_WAIT_L(0); PG8_MMA(0, 1, At, B1); PG8_BAR;
            PG8_LDA(At, 0, 1); PG8_STAGE(PG8_SA(0, 0), a2, voffA);
            PG8_BAR; PG8_WAIT_L(0); PG8_MMA(1, 0, At, B0); PG8_BAR; PG8_SCHED;
            PG8_STAGE(PG8_SB(0, 1), b2 + hstepB, voffB);
            PG8_WAIT_V(6); PG8_BAR; PG8_MMA(1, 1, At, B1); PG8_BAR;
            PG8_LDB(B0, 1, 0); PG8_SCHED; PG8_LDA(At, 1, 0); PG8_STAGE(PG8_SA(0, 1), a2 + hstepA, voffA);
            PG8_WAIT_L(8); PG8_BAR; PG8_WAIT_L(0); PG8_MMA(0, 0, At, B0); PG8_BAR; PG8_SCHED;
            PG8_LDB(B1, 1, 1); PG8_STAGE(PG8_SB(1, 0), b3, voffB);
            PG8_BAR; PG8_WAIT_L(0); PG8_MMA(0, 1, At, B1); PG8_BAR;
            PG8_LDA(At, 1, 1); PG8_STAGE(PG8_SA(1, 0), a3, voffA);
            PG8_BAR; PG8_WAIT_L(0); PG8_MMA(1, 0, At, B0); PG8_BAR; PG8_SCHED;
            PG8_STAGE(PG8_SB(1, 1), b3 + hstepB, voffB);
            PG8_WAIT_V(6); PG8_BAR; PG8_MMA(1, 1, At, B1); PG8_BAR;
            }
        }
        if constexpr (ALIGN_EPI) { if (wr == 0) PG8_BAR; }
        O.epi(acc, cur, wr, wc, fr, fq, (const LAS float*)(lds + STAGE_BYTES + (ui & 1) * 1024));
        if (!has_next) break;
        if (!O.keep(cur)) {
#pragma unroll
        for (int a = 0; a < 2; ++a)
#pragma unroll
            for (int b = 0; b < 2; ++b)
#pragma unroll
                for (int m = 0; m < 4; ++m)
#pragma unroll
                    for (int n = 0; n < 2; ++n) acc[a][b][m][n] = (f32x4){0.f, 0.f, 0.f, 0.f};
        }
        cur = nxt; cA = nA; cB = nB; ++ui;
        PG8_BIAS(cur, ui & 1);
        if constexpr (ALIGN_EPI) { if (wr == 1) PG8_BAR; }
    }
    PG8_WAIT_V(0);
    if constexpr (!ALIGN_EPI) { if (wr == 0) PG8_BAR; }
    PG8_BAR;
#undef PG8_BIAS
#undef PG8_SA
#undef PG8_SB
#undef PG8_STAGE
#undef PG8_LDA
#undef PG8_LDB
#undef PG8_MMA
#undef PG8_WAIT_V
#undef PG8_WAIT_L
#undef PG8_BAR
#undef PG8_SCHED
}
}
using pg8::Unit;

template <int WGM = 8>
__device__ __forceinline__ void tile_order(int L, int nM, int nN, int& pm, int& pn) {
    const int nwg = nM * nN; int wgid = L;
    { const int q = nwg / 8, r = nwg % 8, xcd = wgid % 8, off = wgid / 8; wgid = (xcd < r ? xcd * (q + 1) : r * (q + 1) + (xcd - r) * q) + off; }
    const int nig = WGM * nN, gid = wgid / nig, fm = gid * WGM, gsz = (nM - fm) < WGM ? (nM - fm) : WGM;
    pm = fm + ((wgid % nig) % gsz); pn = (wgid % nig) / gsz;
}

struct OpIn {
    static constexpr bool PERM = true, LDS_BIAS = true;
    __device__ __forceinline__ const float* bias_ptr(const Unit& u) const { return (const float*)(ws + WS_BIASP) + u.pn * 256; }
    unsigned char* ws; unsigned lda, ldb, akstep; int nt;
    __device__ __forceinline__ bool get(int ui, int c, int G, Unit& u) const { const int L = ui * G + c; if (L >= 64 * 43) return false; tile_order<4>(L, 64, 43, u.pm, u.pn); u.sub = 0; return true; }
    __device__ __forceinline__ const char* a_ptr(const Unit& u) const { return (const char*)(ws + WS_HB) + (size_t)u.pm * 256 * lda; }
    __device__ __forceinline__ const char* b_ptr(const Unit& u) const { return (const char*)(ws + WS_WTIN) + (size_t)u.pn * 256 * ldb; }
    __device__ __forceinline__ bool keep(const Unit&) const { return false; }
    __device__ __forceinline__ void epi(f32x4 (&acc)[2][2][4][2], const Unit& u, int wr, int wc, int fr, int fq, const LAS float* lb) const {
        const int pn = u.pn;
        const int row0 = u.pm * 256 + wr * 64 + fr;
        const int ct0 = wc * 32 + 8 * fq;
        f32x4 bv[2][2];
#pragma unroll
        for (int bj = 0; bj < 2; ++bj)
#pragma unroll
            for (int n = 0; n < 2; ++n) bv[bj][n] = *(const LAS f32x4*)(lb + ct0 + bj * 128 + 4 * n);
        int mode = 0;
        bf16_t* base = nullptr; int ld = LDPA; int tbase = 0;
        int trows = 256; bool tiled = false;
        if (pn < 4) { mode = 1; base = (bf16_t*)(ws + WS_PA) + PA_Q + pn * 256; }
        else if (pn == 4) { base = (bf16_t*)(ws + WS_PA) + PA_CK; }
        else if (pn == 5) { base = (bf16_t*)(ws + WS_PA) + PA_CV; }
        else if (pn == 6) { mode = 6; base = (bf16_t*)(ws + WS_SKB); }
        else if (pn == 7) { mode = 4; base = (bf16_t*)(ws + WS_SVT); trows = 256; tbase = 0; tiled = true; }
        else if (pn == 8) { mode = 6; base = (bf16_t*)(ws + WS_WKB); }
        else if (pn == 9) { mode = 4; base = (bf16_t*)(ws + WS_WVT); trows = 256; tbase = 0; tiled = true; }
        else if (pn < 14) { mode = 2; base = (bf16_t*)(ws + WS_PA) + PA_ZN + (pn - 10) * 256; }
        else if (pn < 16) { base = (bf16_t*)(ws + WS_PA) + PA_GQ + (pn - 14) * 256; }
        else if (pn < 18) { base = (bf16_t*)(ws + WS_PA) + PA_GK + (pn - 16) * 256; }
        else if (pn < 22) { mode = 4; base = (bf16_t*)(ws + WS_GVT); trows = 1024; tbase = (pn - 18) * 256; }
        else if (pn < 26) { mode = 2; base = (bf16_t*)(ws + WS_PA) + PA_ZG + (pn - 22) * 256; }
        else if (pn < 42) { mode = 3; base = (bf16_t*)(ws + WS_PB) + (pn - 26) * 256; ld = LDPB; }
        else { mode = 5; }
        if (mode <= 3) {
#pragma unroll
            for (int ai = 0; ai < 2; ++ai)
#pragma unroll
                for (int m = 0; m < 4; ++m) { bf16_t* rowp = base + (size_t)(row0 + ai * 128 + m * 16) * ld + ct0;
#pragma unroll
                    for (int bj = 0; bj < 2; ++bj) { f32x4 v0 = acc[ai][bj][m][0] + bv[bj][0], v1 = acc[ai][bj][m][1] + bv[bj][1];
                        if (mode == 1) { v0 = v0 * QSCALE; v1 = v1 * QSCALE; }
                        else if (mode == 2) {
#pragma unroll
                            for (int e = 0; e < 4; ++e) { v0[e] = siluf_(v0[e]); v1[e] = siluf_(v1[e]); } }
                        else if (mode == 3) {
#pragma unroll
                            for (int e = 0; e < 4; ++e) { v0[e] = sigmoidf_(v0[e]); v1[e] = sigmoidf_(v1[e]); } }
                        u32x4 w; w.x = pk2(v0[0], v0[1]); w.y = pk2(v0[2], v0[3]); w.z = pk2(v1[0], v1[1]); w.w = pk2(v1[2], v1[3]);
                        *(u32x4*)(rowp + bj * 128) = w; } }
        } else if (mode == 6) {
#pragma unroll
            for (int ai = 0; ai < 2; ++ai)
#pragma unroll
                for (int m = 0; m < 4; ++m) { const int row = row0 + ai * 128 + m * 16; const int b = row >> 13, t = row & 8191;
#pragma unroll
                    for (int bj = 0; bj < 2; ++bj) { const int c = ct0 + bj * 128; const f32x4 v0 = acc[ai][bj][m][0] + bv[bj][0], v1 = acc[ai][bj][m][1] + bv[bj][1];
                        u32x4 w; w.x = pk2(v0[0], v0[1]); w.y = pk2(v0[2], v0[3]); w.z = pk2(v1[0], v1[1]); w.w = pk2(v1[2], v1[3]);
                        *(u32x4*)(base + ((size_t)((b * 4 + (c >> 6)) * T_ + t)) * 64 + (c & 63)) = w; } }
        } else if (mode == 4) {
#pragma unroll
            for (int ai = 0; ai < 2; ++ai)
#pragma unroll
                for (int m = 0; m < 4; ++m) { const int row = row0 + ai * 128 + m * 16; const int b = row >> 13, t = row & 8191;
                    bf16_t* colp = base + ((size_t)(b * trows + tbase + ct0)) * T_ + t;
#pragma unroll
                    for (int bj = 0; bj < 2; ++bj)
#pragma unroll
                        for (int n = 0; n < 2; ++n) { const f32x4 v = acc[ai][bj][m][n] + bv[bj][n];
#pragma unroll
                            for (int e = 0; e < 4; ++e) { const unsigned p = pk2(v[e], 0.f);
                                if (tiled) { const int c = ct0 + bj * 128 + 4 * n + e;
                                    base[((size_t)(((b * 4 + (c >> 6)) * 128 + (t >> 6)) * 64 + (c & 63))) * 64 + (t & 63)] = (bf16_t)(p & 0xffffu); }
                                else colp[(size_t)(bj * 128 + 4 * n + e) * T_] = (bf16_t)(p & 0xffffu); } } }
        } else {
            if (wc < 2) {
                float* sm = (float*)(ws + WS_SM);
#pragma unroll
                for (int ai = 0; ai < 2; ++ai)
#pragma unroll
                    for (int m = 0; m < 4; ++m) { const int row = row0 + ai * 128 + m * 16;
#pragma unroll
                        for (int n = 0; n < 2; ++n) { f32x4 v = acc[ai][0][m][n] + bv[0][n]; const int c0 = ct0 + 4 * n;
                            if (c0 < 48) {
#pragma unroll
                                for (int e = 0; e < 4; ++e) v[e] = sigmoidf_(v[e]); }
                            *(f32x4*)(sm + (size_t)row * 64 + c0) = v; } }
            }
        }
    }
};

struct OpCmp {
    static constexpr bool PERM = true, LDS_BIAS = true;
    __device__ __forceinline__ const float* bias_ptr(const Unit& u) const { return (const float*)(ws + WS_SSQ) + u.sub * 256; }
    unsigned char* ws; unsigned lda, ldb, akstep; int nt;
    __device__ __forceinline__ bool get(int ui, int c, int G, Unit& u) const { const int L = ui * G + c; if (L >= 32) return false; u.pm = L & 15; u.pn = 0; u.sub = L >> 4; return true; }
    __device__ __forceinline__ const char* a_ptr(const Unit& u) const {
        const int bg = u.pm >> 1, n0 = (u.pm & 1) * 256, b = bg >> 2, g = bg & 3;
        return (const char*)(ws + WS_PA) + ((size_t)(b * T_ + 16 * n0) * LDPA + (u.sub ? PA_CV : PA_CK) + g * 64) * 2; }
    __device__ __forceinline__ const char* b_ptr(const Unit& u) const { return (const char*)(ws + WS_W1T) + (size_t)u.sub * 256 * 2048 * 2; }
    __device__ __forceinline__ bool keep(const Unit&) const { return false; }
    __device__ __forceinline__ void epi(f32x4 (&acc)[2][2][4][2], const Unit& u, int wr, int wc, int fr, int fq, const LAS float* lb) const {
        const int row0 = u.pm * 256 + wr * 64 + fr, ct0 = wc * 32 + 8 * fq;
        bf16_t* hid = (bf16_t*)(ws + WS_HID) + (size_t)u.sub * 4096 * 256;
        f32x4 bv[2][2];
#pragma unroll
        for (int bj = 0; bj < 2; ++bj)
#pragma unroll
            for (int n = 0; n < 2; ++n) bv[bj][n] = *(const LAS f32x4*)(lb + ct0 + bj * 128 + 4 * n);
#pragma unroll
        for (int ai = 0; ai < 2; ++ai)
#pragma unroll
            for (int m = 0; m < 4; ++m) { bf16_t* rowp = hid + (size_t)(row0 + ai * 128 + m * 16) * 256 + ct0;
#pragma unroll
                for (int bj = 0; bj < 2; ++bj) { f32x4 v0 = acc[ai][bj][m][0] + bv[bj][0], v1 = acc[ai][bj][m][1] + bv[bj][1];
#pragma unroll
                    for (int e = 0; e < 4; ++e) { v0[e] = siluf_(v0[e]); v1[e] = siluf_(v1[e]); }
                    u32x4 w; w.x = pk2(v0[0], v0[1]); w.y = pk2(v0[2], v0[3]); w.z = pk2(v1[0], v1[1]); w.w = pk2(v1[2], v1[3]);
                    *(u32x4*)(rowp + bj * 128) = w; } }
    }
};

struct OpMerge {
    static constexpr bool PERM = true, LDS_BIAS = false;
    __device__ __forceinline__ const float* bias_ptr(const Unit&) const { return nullptr; }
    unsigned char* ws; unsigned lda, ldb, akstep; int nt;
    __device__ __forceinline__ bool get(int ui, int c, int G, Unit& u) const { const int L = (ui >> 1) * G + c; if (L >= 64 * 8) return false; tile_order<4>(L, 64, 8, u.pm, u.pn); u.sub = ui & 1; return true; }
    __device__ __forceinline__ const char* a_ptr(const Unit& u) const { return (const char*)(ws + WS_PA) + ((size_t)u.pm * 256 * LDPA + (u.sub ? PA_ZG : PA_Q)) * 2; }
    __device__ __forceinline__ const char* b_ptr(const Unit& u) const { return (const char*)(ws + WS_WTBR) + ((size_t)u.pn * 256 * 2048 + (u.sub ? 1024 : 0)) * 2; }
    __device__ __forceinline__ bool keep(const Unit& u) const { return u.sub == 0; }
    __device__ __forceinline__ void epi(f32x4 (&acc)[2][2][4][2], const Unit& u, int wr, int wc, int fr, int fq, const LAS float* lb) const {
        const int row0 = u.pm * 256 + wr * 64 + fr, col0 = u.pn * 256 + wc * 32 + 8 * fq;
        const bf16_t* pb = (const bf16_t*)(ws + WS_PB);
        bf16_t* mg = (bf16_t*)(ws + WS_HB);
#pragma unroll
        for (int ai = 0; ai < 2; ++ai)
#pragma unroll
            for (int m = 0; m < 4; ++m) { const size_t row = (size_t)(row0 + ai * 128 + m * 16);
#pragma unroll
                for (int bj = 0; bj < 2; ++bj) {
                    const u32x4 s2 = *(const u32x4*)(pb + row * LDPB + 2048 + col0 + bj * 128);
                    if (u.sub == 0) {
                        const u32x4 s1 = *(const u32x4*)(pb + row * LDPB + col0 + bj * 128);
                        f32x4& v0 = acc[ai][bj][m][0]; f32x4& v1 = acc[ai][bj][m][1];
                        v0[0] *= bflo(s1.x) * __builtin_amdgcn_rcpf(bflo(s2.x)); v0[1] *= bfhi(s1.x) * __builtin_amdgcn_rcpf(bfhi(s2.x));
                        v0[2] *= bflo(s1.y) * __builtin_amdgcn_rcpf(bflo(s2.y)); v0[3] *= bfhi(s1.y) * __builtin_amdgcn_rcpf(bfhi(s2.y));
                        v1[0] *= bflo(s1.z) * __builtin_amdgcn_rcpf(bflo(s2.z)); v1[1] *= bfhi(s1.z) * __builtin_amdgcn_rcpf(bfhi(s2.z));
                        v1[2] *= bflo(s1.w) * __builtin_amdgcn_rcpf(bflo(s2.w)); v1[3] *= bfhi(s1.w) * __builtin_amdgcn_rcpf(bfhi(s2.w));
                    } else {
                        const f32x4 v0 = acc[ai][bj][m][0], v1 = acc[ai][bj][m][1];
                        u32x4 w; w.x = pk2(v0[0] * bflo(s2.x), v0[1] * bfhi(s2.x)); w.y = pk2(v0[2] * bflo(s2.y), v0[3] * bfhi(s2.y));
                        w.z = pk2(v1[0] * bflo(s2.z), v1[1] * bfhi(s2.z)); w.w = pk2(v1[2] * bflo(s2.w), v1[3] * bfhi(s2.w));
                        *(u32x4*)(mg + row * 2048 + col0 + bj * 128) = w;
                    } } }
    }
};

struct OpOut {
    static constexpr bool PERM = true, LDS_BIAS = true;
    __device__ __forceinline__ const float* bias_ptr(const Unit& u) const { return (const float*)(ws + WS_GATE) + ((u.pm * 256) >> 13) * 2048 + u.pn * 256; }
    unsigned char* ws; const float* x; float* out; unsigned lda, ldb, akstep; int nt;
    __device__ __forceinline__ bool get(int ui, int c, int G, Unit& u) const { const int L = ui * G + c; if (L >= 64 * 8) return false; tile_order<4>(L, 64, 8, u.pm, u.pn); u.sub = 0; return true; }
    __device__ __forceinline__ const char* a_ptr(const Unit& u) const { return (const char*)(ws + WS_HB) + (size_t)u.pm * 256 * 2048 * 2; }
    __device__ __forceinline__ const char* b_ptr(const Unit& u) const { return (const char*)(ws + WS_WTOUT) + (size_t)u.pn * 256 * 2048 * 2; }
    __device__ __forceinline__ bool keep(const Unit&) const { return false; }
    __device__ __forceinline__ void epi(f32x4 (&acc)[2][2][4][2], const Unit& u, int wr, int wc, int fr, int fq, const LAS float* lb) const {
        const int row0 = u.pm * 256 + wr * 64 + fr, col0 = u.pn * 256 + wc * 32 + 8 * fq;
        bf16_t* dl = (bf16_t*)(ws + WS_PA);
        const int ct0 = wc * 32 + 8 * fq;
        f32x4 gv[2][2];
#pragma unroll
        for (int bj = 0; bj < 2; ++bj)
#pragma unroll
            for (int n = 0; n < 2; ++n) gv[bj][n] = *(const LAS f32x4*)(lb + ct0 + bj * 128 + 4 * n);
#pragma unroll
        for (int ai = 0; ai < 2; ++ai)
#pragma unroll
            for (int m = 0; m < 4; ++m) { bf16_t* rowp = dl + (size_t)(row0 + ai * 128 + m * 16) * 2048 + col0;
#pragma unroll
                for (int bj = 0; bj < 2; ++bj) { const f32x4 v0 = gv[bj][0] * acc[ai][bj][m][0], v1 = gv[bj][1] * acc[ai][bj][m][1];
                    u32x4 w; w.x = pk2(v0[0], v0[1]); w.y = pk2(v0[2], v0[3]); w.z = pk2(v1[0], v1[1]); w.w = pk2(v1[2], v1[3]);
                    *(u32x4*)(rowp + bj * 128) = w; } }
    }
};

__device__ __forceinline__ void tr_item(const float* src, int ldsrc, int k0, int scol, bf16_t* dst, int lddst, int n0, int kd0, LAS float* scr, int lane) {
    float tv[32];
#pragma unroll
    for (int i = 0; i < 32; ++i) { const int kk = 2 * i + (lane >> 5); tv[i] = scol >= 0 ? src[(size_t)(k0 + kk) * ldsrc + scol] : 0.f; }
#pragma unroll
    for (int i = 0; i < 32; ++i) { const int kk = 2 * i + (lane >> 5); scr[kk * 33 + (lane & 31)] = tv[i]; }
    LDS_WAIT();
    const int c = lane & 7;
#pragma unroll
    for (int j = 0; j < 4; ++j) { const int n = (lane >> 3) + 8 * j; const LAS float* s = scr + (8 * c) * 33 + n;
        u32x4 o; o.x = pk2(s[0 * 33], s[1 * 33]); o.y = pk2(s[2 * 33], s[3 * 33]); o.z = pk2(s[4 * 33], s[5 * 33]); o.w = pk2(s[6 * 33], s[7 * 33]);
        *(u32x4*)(dst + (size_t)(n0 + n) * lddst + kd0 + k0 + 8 * c) = o; }
    LDS_WAIT();
}
__device__ __forceinline__ int in_orig_col(int n) {
    if (n < 2560) return n;
    if (n < 5632) return n + 48;
    if (n < 10752) return n + 64;
    if (n < 10800) return 2560 + (n - 10752);
    if (n < 10816) return 5680 + (n - 10800);
    return -1;
}
__device__ __forceinline__ void p0_phase(const Args& a, LAS unsigned char* lds, int G) {
    const int tid = threadIdx.x, lane = tid & 63, wave = tid >> 6;
    unsigned char* ws = a.ws;
    LAS float* scr = (LAS float*)(lds + wave * 16384);
    const int gw = blockIdx.x * 8 + wave, NGW = G * 8;
    constexpr int I_IN = 32 * 344, I_BR = 16 * 64, I_OUT = 32 * 64, I_W1 = 32 * 8, I_W2 = 4 * 2, I_ADA = 16 * 96, I_BIAS = 172, I_CB = 2 * 4 * 8;
    constexpr int NITEMS = I_IN + 2 * I_BR + I_OUT + 2 * I_W1 + 2 * I_W2 + I_ADA + I_BIAS + I_CB;
    for (int it = gw; it < NITEMS; it += NGW) {
        int r = it;
        if (r < I_IN) { const int kb = r / 344, nb = r % 344; tr_item(a.in[5], NREAL, 64 * kb, in_orig_col(32 * nb + (lane & 31)), (bf16_t*)(ws + WS_WTIN), 2048, 32 * nb, 0, scr, lane); continue; } r -= I_IN;
        if (r < I_BR) { const int kb = r / 64, nb = r % 64; tr_item(a.in[16], 2048, 64 * kb, 32 * nb + (lane & 31), (bf16_t*)(ws + WS_WTBR), 2048, 32 * nb, 0, scr, lane); continue; } r -= I_BR;
        if (r < I_BR) { const int kb = r / 64, nb = r % 64; tr_item(a.in[17], 2048, 64 * kb, 32 * nb + (lane & 31), (bf16_t*)(ws + WS_WTBR), 2048, 32 * nb, 1024, scr, lane); continue; } r -= I_BR;
        if (r < I_OUT) { const int kb = r / 64, nb = r % 64; tr_item(a.in[18], 2048, 64 * kb, 32 * nb + (lane & 31), (bf16_t*)(ws + WS_WTOUT), 2048, 32 * nb, 0, scr, lane); continue; } r -= I_OUT;
        if (r < I_W1) { const int kb = r / 8, nb = r % 8; tr_item(a.in[9], 256, 64 * kb, 32 * nb + (lane & 31), (bf16_t*)(ws + WS_W1T), 2048, 32 * nb, 0, scr, lane); continue; } r -= I_W1;
        if (r < I_W1) { const int kb = r / 8, nb = r % 8; tr_item(a.in[11], 256, 64 * kb, 32 * nb + (lane & 31), (bf16_t*)(ws + WS_W1T) + 256 * 2048, 2048, 32 * nb, 0, scr, lane); continue; } r -= I_W1;
        if (r < I_W2) { const int kb = r / 2, nb = r % 2; tr_item(a.in[10], 64, 64 * kb, 32 * nb + (lane & 31), (bf16_t*)(ws + WS_W2T), 256, 32 * nb, 0, scr, lane); continue; } r -= I_W2;
        if (r < I_W2) { const int kb = r / 2, nb = r % 2; tr_item(a.in[12], 64, 64 * kb, 32 * nb + (lane & 31), (bf16_t*)(ws + WS_W2T) + 64 * 256, 256, 32 * nb, 0, scr, lane); continue; } r -= I_W2;
        if (r < I_ADA) {
            const int kc = r / 96, j = (r % 96) * 64 + lane; const float* w = a.in[2] + (size_t)(kc * 128) * 6144 + j; const float* c0 = a.in[1] + kc * 128; const float* c1 = c0 + 2048;
            float s0 = 0.f, s1 = 0.f;
#pragma unroll 16
            for (int k = 0; k < 128; ++k) { const float wv = w[(size_t)k * 6144]; s0 += c0[k] * wv; s1 += c1[k] * wv; }
            float* ap = (float*)(ws + WS_APART) + (size_t)kc * 2 * 6144; ap[j] = s0; ap[6144 + j] = s1; continue; } r -= I_ADA;
        if (r < I_BIAS) { const int n = r * 64 + lane; const int oc = in_orig_col(n); ((float*)(ws + WS_BIASP))[n] = oc >= 0 ? a.in[6][oc] : 0.f; continue; } r -= I_BIAS;
        {
            const int which = r >> 5, jc = (r >> 3) & 3, kc = r & 7, j = jc * 64 + lane;
            const float* pos = a.in[which ? 8 : 7] + kc * 256; const float* w = a.in[which ? 11 : 9] + (size_t)(kc * 256) * 256 + j; float s = 0.f;
#pragma unroll 8
            for (int k = 0; k < 256; ++k) s += pos[k] * w[(size_t)k * 256];
            ((float*)(ws + WS_CB1P))[which * 2048 + kc * 256 + j] = s; }
    }
}

__device__ __forceinline__ void p1_phase(const Args& a, LAS unsigned char* lds, int G) {
    const int tid = threadIdx.x, lane = tid & 63, wave = tid >> 6;
    unsigned char* ws = a.ws;
    const float* ap = (const float*)(ws + WS_APART);
    const float* bada = a.in[3];
    for (int idx = blockIdx.x * 512 + tid; idx < 4096; idx += G * 512) { const int b = idx >> 11, k = idx & 2047; float s = bada[4096 + k];
        for (int kc = 0; kc < 16; ++kc) s += ap[(size_t)kc * 2 * 6144 + b * 6144 + 4096 + k];
        ((float*)(ws + WS_GATE))[idx] = s; }
    for (int idx = blockIdx.x * 512 + tid; idx < 512; idx += G * 512) { const float* cb = (const float*)(ws + WS_CB1P) + (idx >> 8) * 2048 + (idx & 255); float s = 0.f;
        for (int p = 0; p < 8; ++p) s += cb[p * 256];
        ((float*)(ws + WS_SSQ))[idx] = s; }
    LAS float* gsc = (LAS float*)lds; LAS float* sh = gsc + 2048;
    for (int chunk = blockIdx.x; chunk < 256; chunk += G) {
        const int b = chunk >> 7;
        __syncthreads();
        for (int k = tid; k < 2048; k += 512) { float s0 = bada[k], s1 = bada[2048 + k];
            for (int kc = 0; kc < 16; ++kc) { const float* p = ap + (size_t)kc * 2 * 6144 + b * 6144; s0 += p[k]; s1 += p[2048 + k]; }
            sh[k] = s0; gsc[k] = (1.f + s1) * a.in[4][k]; }
        __syncthreads();
        for (int rr = wave; rr < 64; rr += 8) {
            const int row = chunk * 64 + rr;
            const f32x4* xr = (const f32x4*)(a.in[0] + (size_t)row * 2048) + lane;
            f32x4 v[8]; float s = 0.f;
#pragma unroll
            for (int j = 0; j < 8; ++j) { v[j] = xr[64 * j]; s += (v[j][0] * v[j][0] + v[j][1] * v[j][1]) + (v[j][2] * v[j][2] + v[j][3] * v[j][3]); }
            const float rstd = 1.0f / sqrtf(wave_sum(s) * (1.f / 2048.f) + EPS_);
            u32x2* o = (u32x2*)((bf16_t*)(ws + WS_HB) + (size_t)row * 2048) + lane;
#pragma unroll
            for (int j = 0; j < 8; ++j) { const int k = (lane + 64 * j) * 4; const f32x4 g4 = *(const LAS f32x4*)(gsc + k), s4 = *(const LAS f32x4*)(sh + k);
                u32x2 w; w.x = pk2(v[j][0] * rstd * g4[0] + s4[0], v[j][1] * rstd * g4[1] + s4[1]); w.y = pk2(v[j][2] * rstd * g4[2] + s4[2], v[j][3] * rstd * g4[3] + s4[3]);
                o[64 * j] = w; }
        }
    }
}

constexpr int GL_GA = 32768, GL_TOT = 36864, GL_QP = 40960, GL_KP = 57344, GL_AL = 73728, GL_SSQ = 81920;

__device__ __forceinline__ void gla_cumsum(const Args& a, LAS unsigned char* lds, int b, int h, int c, float (&bv)[16], float& blast) {
    const int tid = threadIdx.x, k = tid & 127, ig = tid >> 7;
    const float* sm = (const float*)(a.ws + WS_SM);
    LAS float* GA = (LAS float*)(lds + GL_GA); LAS float* TOT = (LAS float*)(lds + GL_TOT);
    const int tok0 = b * T_ + c * 64;
    __syncthreads();
    { const int idx = tid * 2, i = idx >> 4, r = idx & 15; const f32x2 v = *(const f32x2*)(sm + (size_t)(tok0 + i) * 64 + 48 + r); GA[idx] = v[0]; GA[idx + 1] = v[1]; }
    float wa[16];
#pragma unroll
    for (int r = 0; r < 16; ++r) wa[r] = a.in[13][r * 512 + h * 128 + k];
    const float ba = a.in[14][h * 128 + k];
    __syncthreads();
    float run = 0.f;
#pragma unroll
    for (int e = 0; e < 16; ++e) { const LAS float* g = GA + (16 * ig + e) * 16; float x = ba;
#pragma unroll
        for (int r = 0; r < 16; ++r) x += g[r] * wa[r];
        const float sp = fmaxf(-x, 0.f) + LN2 * __builtin_amdgcn_logf(1.f + ex2(-fabsf(x) * LOG2E));
        run -= sp * 0.0625f; bv[e] = run; }
    TOT[ig * 128 + k] = run;
    __syncthreads();
    float pre = 0.f, tot = 0.f;
#pragma unroll
    for (int g = 0; g < 4; ++g) { const float t = TOT[g * 128 + k]; if (g < ig) pre += t; tot += t; }
#pragma unroll
    for (int e = 0; e < 16; ++e) bv[e] += pre;
    blast = tot;
}

__device__ __forceinline__ size_t us_off(int bh, int c, int v) { return ((size_t)((bh * 32 + (v >> 3)) * 128 + c) * 8 + (v & 7)) * 128; }
__device__ __forceinline__ void gla_pass_a(const Args& a, LAS unsigned char* lds, int item) {
    const int tid = threadIdx.x, lane = tid & 63, wave = tid >> 6, fr = lane & 15, fq = lane >> 4, k = tid & 127, ig = tid >> 7;
    const int bh = item >> 7, c = item & 127, b = bh >> 2, h = bh & 3;
    unsigned char* ws = a.ws;
    float bv[16], blast;
    gla_cumsum(a, lds, b, h, c, bv, blast);
    if (ig == 0) ((float*)(ws + WS_GAM))[(size_t)(bh * 128 + c) * 128 + k] = fexp(blast);
    LAS unsigned char* KT = lds + GL_QP;
    const bf16_t* gk = (const bf16_t*)(ws + WS_PA) + (size_t)(b * T_ + c * 64 + 16 * ig) * LDPA + PA_GK + h * 128 + k;
    {
        float kv[16];
#pragma unroll
        for (int e = 0; e < 16; ++e) kv[e] = bf2f(gk[(size_t)e * LDPA]) * fexp(blast - bv[e]);
        u32x4 w0, w1; w0.x = pk2(kv[0], kv[1]); w0.y = pk2(kv[2], kv[3]); w0.z = pk2(kv[4], kv[5]); w0.w = pk2(kv[6], kv[7]);
        w1.x = pk2(kv[8], kv[9]); w1.y = pk2(kv[10], kv[11]); w1.z = pk2(kv[12], kv[13]); w1.w = pk2(kv[14], kv[15]);
        *(LAS u32x4*)(KT + k * 128 + (((2 * ig) ^ (k & 7)) << 4)) = w0;
        *(LAS u32x4*)(KT + k * 128 + (((2 * ig + 1) ^ (k & 7)) << 4)) = w1;
    }
    __syncthreads();
    const bf16_t* gvt = (const bf16_t*)(ws + WS_GVT) + (size_t)(b * 1024 + h * 256 + 32 * wave) * T_ + c * 64;
    bf16x8 vf[2][2];
#pragma unroll
    for (int vt = 0; vt < 2; ++vt)
#pragma unroll
        for (int js = 0; js < 2; ++js) vf[vt][js] = *(const bf16x8*)(gvt + (size_t)(16 * vt + fr) * T_ + 32 * js + 8 * fq);
    bf16_t* us = (bf16_t*)(ws + WS_HB);
#pragma unroll
    for (int kt = 0; kt < 8; ++kt) {
        const int kr = 16 * kt + fr;
        const bf16x8 k0 = *(const LAS bf16x8*)(KT + kr * 128 + (((fq) ^ (kr & 7)) << 4));
        const bf16x8 k1 = *(const LAS bf16x8*)(KT + kr * 128 + (((4 + fq) ^ (kr & 7)) << 4));
#pragma unroll
        for (int vt = 0; vt < 2; ++vt) { f32x4 acc = (f32x4){0.f, 0.f, 0.f, 0.f};
            acc = __builtin_amdgcn_mfma_f32_16x16x32_bf16(k0, vf[vt][0], acc, 0, 0, 0);
            acc = __builtin_amdgcn_mfma_f32_16x16x32_bf16(k1, vf[vt][1], acc, 0, 0, 0);
            u32x2 w; w.x = pk2(acc[0], acc[1]); w.y = pk2(acc[2], acc[3]);
            *(u32x2*)(us + us_off(bh, c, 32 * wave + 16 * vt + fr) + 16 * kt + 4 * fq) = w; }
    }
}

__device__ __forceinline__ void gla_scan(const Args& a, int G, bool dummy) {
    unsigned char* ws = a.ws;
    for (int blk = blockIdx.x; blk < 256; blk += G) {
        const int bh = blk >> 5, k2 = (threadIdx.x & 63) * 2;
        unsigned* p = (unsigned*)((bf16_t*)(ws + WS_HB) + (size_t)blk * 128 * 1024 + threadIdx.x * 2);
        const f32x2* gm = (const f32x2*)((const float*)(ws + WS_GAM) + (size_t)bh * 128 * 128 + k2);
        float s0 = 0.f, s1 = 0.f;
#pragma unroll 32
        for (int c = 0; c < 128; ++c) { const unsigned u = p[c * 512]; const f32x2 g = gm[c * 64];
            (dummy ? (unsigned*)(ws + WS_WTIN) + (((size_t)blk * 128 * 512 + threadIdx.x) & 0x7fffffu) : p)[c * 512] = pk2(s0, s1); s0 = g[0] * s0 + bflo(u); s1 = g[1] * s1 + bfhi(u); }
    }
}

__device__ __forceinline__ void gla_pass_c(const Args& a, LAS unsigned char* lds, int item, bf16_t* ydst, int ldy) {
    const int tid = threadIdx.x, lane = tid & 63, wave = tid >> 6, fr = lane & 15, fq = lane >> 4, k = tid & 127, ig = tid >> 7;
    const int bh = item >> 7, c = item & 127, b = bh >> 2, h = bh & 3;
    unsigned char* ws = a.ws;
    float bv[16], blast;
    const int tok0 = b * T_ + c * 64;
    bf16_t qraw[16], kraw[16];
    {
        const bf16_t* gq = (const bf16_t*)(ws + WS_PA) + (size_t)(tok0 + 16 * ig) * LDPA + PA_GQ + h * 128 + k;
        const bf16_t* gk = gq + (PA_GK - PA_GQ);
#pragma unroll
        for (int e = 0; e < 16; ++e) { qraw[e] = gq[(size_t)e * LDPA]; kraw[e] = gk[(size_t)e * LDPA]; }
    }
    gla_cumsum(a, lds, b, h, c, bv, blast);
    LAS unsigned char* QP = lds + GL_QP; LAS unsigned char* KP = lds + GL_KP; LAS unsigned char* AL = lds + GL_AL; LAS float* SSQ = (LAS float*)(lds + GL_SSQ);
    {
        const int ck = k >> 3, ko = (k & 7) * 2;
#pragma unroll
        for (int e = 0; e < 16; ++e) { const int i = 16 * ig + e; const int off = i * 256 + ((ck ^ (i & 7)) << 4) + ko;
            const float qv = bf2f(qraw[e]) * fexp(bv[e]) * 0.08838834764831845f;
            const float kv = bf2f(kraw[e]) * fexp(-bv[e]);
            *(LAS bf16_t*)(QP + off) = (bf16_t)(pk2(qv, 0.f) & 0xffffu); *(LAS bf16_t*)(KP + off) = (bf16_t)(pk2(kv, 0.f) & 0xffffu); }
    }
    __syncthreads();
    {
        const int it = wave >> 1;
#pragma unroll
        for (int q = 0; q < 2; ++q) { const int jt = (wave & 1) * 2 + q; f32x4 acc = (f32x4){0.f, 0.f, 0.f, 0.f};
            if (jt <= it) {
                const int jr = 16 * jt + fr, ir = 16 * it + fr;
#pragma unroll
                for (int ks = 0; ks < 4; ++ks) {
                    const bf16x8 kf = *(const LAS bf16x8*)(KP + jr * 256 + (((4 * ks + fq) ^ (jr & 7)) << 4));
                    const bf16x8 qf = *(const LAS bf16x8*)(QP + ir * 256 + (((4 * ks + fq) ^ (ir & 7)) << 4));
                    acc = __builtin_amdgcn_mfma_f32_16x16x32_bf16(kf, qf, acc, 0, 0, 0); }
            }
            const int i = 16 * it + fr, j0 = 16 * jt + 4 * fq;
#pragma unroll
            for (int jj = 0; jj < 4; ++jj) if (j0 + jj > i) acc[jj] = 0.f;
            u32x2 w; w.x = pk2(acc[0], acc[1]); w.y = pk2(acc[2], acc[3]);
            *(LAS u32x2*)(AL + i * 128 + ((((j0 >> 3)) ^ (i & 7)) << 4) + (fq & 1) * 8) = w; }
    }
    __syncthreads();
    f32x4 o[2][4];
#pragma unroll
    for (int vt = 0; vt < 2; ++vt)
#pragma unroll
        for (int it = 0; it < 4; ++it) o[vt][it] = (f32x4){0.f, 0.f, 0.f, 0.f};
    {
        const bf16_t* gvt = (const bf16_t*)(ws + WS_GVT) + (size_t)(b * 1024 + h * 256 + 32 * wave) * T_ + c * 64;
#pragma unroll
        for (int js = 0; js < 2; ++js) {
            bf16x8 vf[2];
#pragma unroll
            for (int vt = 0; vt < 2; ++vt) vf[vt] = *(const bf16x8*)(gvt + (size_t)(16 * vt + fr) * T_ + 32 * js + 8 * fq);
#pragma unroll
            for (int it = 0; it < 4; ++it) { const int ir = 16 * it + fr;
                const bf16x8 af = *(const LAS bf16x8*)(AL + ir * 128 + (((4 * js + fq) ^ (ir & 7)) << 4));
#pragma unroll
                for (int vt = 0; vt < 2; ++vt) o[vt][it] = __builtin_amdgcn_mfma_f32_16x16x32_bf16(vf[vt], af, o[vt][it], 0, 0, 0); }
        }
        const bf16_t* st = (const bf16_t*)(ws + WS_HB);
#pragma unroll
        for (int ks = 0; ks < 4; ++ks) {
            bf16x8 sf[2];
#pragma unroll
            for (int vt = 0; vt < 2; ++vt) sf[vt] = *(const bf16x8*)(st + us_off(bh, c, 32 * wave + 16 * vt + fr) + 32 * ks + 8 * fq);
#pragma unroll
            for (int it = 0; it < 4; ++it) { const int ir = 16 * it + fr;
                const bf16x8 qf = *(const LAS bf16x8*)(QP + ir * 256 + (((4 * ks + fq) ^ (ir & 7)) << 4));
#pragma unroll
                for (int vt = 0; vt < 2; ++vt) o[vt][it] = __builtin_amdgcn_mfma_f32_16x16x32_bf16(sf[vt], qf, o[vt][it], 0, 0, 0); }
        }
    }
#pragma unroll
    for (int it = 0; it < 4; ++it) { float s = 0.f;
#pragma unroll
        for (int vt = 0; vt < 2; ++vt) s += (o[vt][it][0] * o[vt][it][0] + o[vt][it][1] * o[vt][it][1]) + (o[vt][it][2] * o[vt][it][2] + o[vt][it][3] * o[vt][it][3]);
        s += __shfl_xor(s, 16); s += __shfl_xor(s, 32);
        if (fq == 0) SSQ[wave * 64 + 16 * it + fr] = s; }
    __syncthreads();
    const float* gn = a.in[15];
#pragma unroll
    for (int it = 0; it < 4; ++it) { const int i = 16 * it + fr; float tot = 0.f;
#pragma unroll
        for (int w = 0; w < 8; ++w) tot += SSQ[w * 64 + i];
        const float rstd = 1.0f / sqrtf(tot * (1.f / 256.f) + EPS_);
        bf16_t* zrow = (bf16_t*)(ws + WS_PA) + (size_t)(tok0 + i) * LDPA + PA_ZG + h * 256 + 32 * wave;
#pragma unroll
        for (int vt = 0; vt < 2; ++vt) { const int v0 = 16 * vt + 4 * fq; const u32x2 z = *(const u32x2*)(zrow + v0); const f32x4 g = *(const f32x4*)(gn + 32 * wave + v0);
            u32x2 w; w.x = pk2(o[vt][it][0] * rstd * g[0] * bflo(z.x), o[vt][it][1] * rstd * g[1] * bfhi(z.x));
            w.y = pk2(o[vt][it][2] * rstd * g[2] * bflo(z.y), o[vt][it][3] * rstd * g[3] * bfhi(z.y));
            *(u32x2*)(ydst + (size_t)(tok0 + i) * ldy + h * 256 + 32 * wave + v0) = w; } }
}

__device__ __forceinline__ void cmp2_item(const Args& a, int item, int lane) {
    const int fr = lane & 15, fq = lane >> 4; unsigned char* ws = a.ws;
    const int which = item >> 8, rt = item & 255;
    const bf16_t* hid = (const bf16_t*)(ws + WS_HID) + ((size_t)which * 4096 + rt * 16) * 256;
    const bf16_t* w2t = (const bf16_t*)(ws + WS_W2T) + (size_t)which * 64 * 256;
    f32x4 acc[4];
#pragma unroll
    for (int dt = 0; dt < 4; ++dt) acc[dt] = (f32x4){0.f, 0.f, 0.f, 0.f};
#pragma unroll
    for (int ks = 0; ks < 8; ++ks) {
        const bf16x8 hf = *(const bf16x8*)(hid + (size_t)fr * 256 + 32 * ks + 8 * fq);
#pragma unroll
        for (int dt = 0; dt < 4; ++dt) { const bf16x8 wf = *(const bf16x8*)(w2t + (size_t)(16 * dt + fr) * 256 + 32 * ks + 8 * fq);
            if (which == 0) acc[dt] = __builtin_amdgcn_mfma_f32_16x16x32_bf16(wf, hf, acc[dt], 0, 0, 0);
            else acc[dt] = __builtin_amdgcn_mfma_f32_16x16x32_bf16(hf, wf, acc[dt], 0, 0, 0); }
    }
    const int row = rt * 16, bg = row >> 9, n0 = row & 511;
#pragma unroll
    for (int dt = 0; dt < 4; ++dt) { u32x2 w; w.x = pk2(acc[dt][0], acc[dt][1]); w.y = pk2(acc[dt][2], acc[dt][3]);
        if (which == 0) *(u32x2*)((bf16_t*)(ws + WS_KC) + ((size_t)bg * 512 + n0 + fr) * 64 + 16 * dt + 4 * fq) = w;
        else { const int n = n0 + 4 * fq; *(u32x2*)((bf16_t*)(ws + WS_VCT) + ((size_t)((bg * 8 + (n >> 6)) * 64 + 16 * dt + fr)) * 64 + (n & 63)) = w; } }
}

constexpr int NS_IMP = 32768, NS_SELM = 65536, NS_UNI = 66560, NS_LIST = 66624, NS_NL = 66752, NS_OUTS = 67584;
constexpr float NEG_INF = -__builtin_inff();

struct TileSrc { const char* k; const char* v; size_t ks, vs; };
__device__ __forceinline__ void tile_load(const TileSrc& s, int tid, u32x4& kr, u32x4& vr) {
    const int row = tid >> 3, ch = tid & 7;
    kr = *(const u32x4*)(s.k + (size_t)row * s.ks + ch * 16); vr = *(const u32x4*)(s.v + (size_t)row * s.vs + ch * 16);
}
__device__ __forceinline__ int swz_k(int row) { return ((row >> 3) & 3) | (((row >> 1) & 1) << 2); }
__device__ __forceinline__ int swz_v(int row) { return (row >> 1) & 7; }
__device__ __forceinline__ void tile_store(LAS unsigned char* buf, int tid, const u32x4& kr, const u32x4& vr) {
    const int row = tid >> 3, ch = tid & 7;
    *(LAS u32x4*)(buf + row * 128 + ((ch ^ swz_k(row)) << 4)) = kr; *(LAS u32x4*)(buf + 8192 + row * 128 + ((ch ^ swz_v(row)) << 4)) = vr;
}
__device__ __forceinline__ void qk_tile(LAS const unsigned char* kb, const bf16x8 (&qf)[2][2], f32x4 (&s)[2][2][2], int fr, int fq) {
#pragma unroll
    for (int kk = 0; kk < 2; ++kk)
#pragma unroll
        for (int aa = 0; aa < 2; ++aa) { const int kr = 32 * kk + 8 * (fr >> 2) + 4 * aa + (fr & 3);
            const bf16x8 k0 = *(const LAS bf16x8*)(kb + kr * 128 + (((fq) ^ swz_k(kr)) << 4));
            const bf16x8 k1 = *(const LAS bf16x8*)(kb + kr * 128 + (((4 + fq) ^ swz_k(kr)) << 4));
#pragma unroll
            for (int h = 0; h < 2; ++h) { s[h][kk][aa] = __builtin_amdgcn_mfma_f32_16x16x32_bf16(k0, qf[h][0], s[h][kk][aa], 0, 0, 0);
                s[h][kk][aa] = __builtin_amdgcn_mfma_f32_16x16x32_bf16(k1, qf[h][1], s[h][kk][aa], 0, 0, 0); } }
}
__device__ __forceinline__ void bias_tile(f32x4 (&s)[2][2][2], float d1, float pstride, float win, bool mask, const float (&slope2)[2], const float (&cm)[2]) {
    if (mask) {
#pragma unroll
        for (int kk = 0; kk < 2; ++kk)
#pragma unroll
            for (int aa = 0; aa < 2; ++aa)
#pragma unroll
                for (int j = 0; j < 4; ++j) { const float rel = d1 + pstride * (float)(32 * kk + 4 * aa + j);
                    const bool valid = (rel <= 0.f) && (rel > -win);
                    s[0][kk][aa][j] = valid ? __builtin_fmaf(slope2[0], rel, cm[0]) : NEG_INF; s[1][kk][aa][j] = valid ? __builtin_fmaf(slope2[1], rel, cm[1]) : NEG_INF; }
    } else {
#pragma unroll
        for (int kk = 0; kk < 2; ++kk)
#pragma unroll
            for (int aa = 0; aa < 2; ++aa)
#pragma unroll
                for (int j = 0; j < 4; ++j) { const float rel = d1 + pstride * (float)(32 * kk + 4 * aa + j);
                    s[0][kk][aa][j] = __builtin_fmaf(slope2[0], rel, cm[0]); s[1][kk][aa][j] = __builtin_fmaf(slope2[1], rel, cm[1]); }
    }
}
__device__ __forceinline__ void pv_tile(LAS const unsigned char* vb, const f32x4 (&p)[2][2][2], f32x4 (&O)[2][4], int fr, int fq) {
#pragma unroll
    for (int kk = 0; kk < 2; ++kk) {
        bf16x8 pf[2];
#pragma unroll
        for (int h = 0; h < 2; ++h) { u32x4 w; w.x = pk2(p[h][kk][0][0], p[h][kk][0][1]); w.y = pk2(p[h][kk][0][2], p[h][kk][0][3]); w.z = pk2(p[h][kk][1][0], p[h][kk][1][1]); w.w = pk2(p[h][kk][1][2], p[h][kk][1][3]); pf[h] = as_bf16x8(w); }
#pragma unroll
        for (int dt = 0; dt < 4; ++dt) { const int dr = 16 * dt + fr;
            const bf16x8 vf = *(const LAS bf16x8*)(vb + dr * 128 + (((4 * kk + fq) ^ swz_v(dr)) << 4));
#pragma unroll
            for (int h = 0; h < 2; ++h) O[h][dt] = __builtin_amdgcn_mfma_f32_16x16x32_bf16(vf, pf[h], O[h][dt], 0, 0, 0); }
    }
}
constexpr float SM_THR = 5.0f;
__device__ __forceinline__ void softmax_tile(f32x4 (&s)[2][2][2], float (&m)[2], float (&l)[2], f32x4 (&O)[2][4], bool scaleO, LAS const unsigned char* vb, int fr, int fq) {
    float mx[2]; bool need = false;
#pragma unroll
    for (int h = 0; h < 2; ++h) {
        float v = NEG_INF;
#pragma unroll
        for (int kk = 0; kk < 2; ++kk)
#pragma unroll
            for (int aa = 0; aa < 2; ++aa) v = fmaxf(v, fmaxf(fmaxf(s[h][kk][aa][0], s[h][kk][aa][1]), fmaxf(s[h][kk][aa][2], s[h][kk][aa][3])));
        mx[h] = v; need = need || ((m[h] == NEG_INF) ? (v > NEG_INF) : (v > SM_THR));
    }
    const unsigned long long needm = __ballot(need);
    if ((needm | __ballot((mx[0] > -150.f) || (mx[1] > -150.f))) != 0ull) {
    if (needm != 0ull) {
#pragma unroll
        for (int h = 0; h < 2; ++h) {
            float q = mx[h]; q = fmaxf(q, __shfl_xor(q, 16)); q = fmaxf(q, __shfl_xor(q, 32));
            const bool unset = (m[h] == NEG_INF);
            const float delta = unset ? ((q == NEG_INF) ? 0.f : q) : fmaxf(q, 0.f);
            const float al = unset ? 1.f : ex2(-delta);
            m[h] = unset ? q : m[h] + delta;
            l[h] *= al;
            if (scaleO) {
#pragma unroll
                for (int dt = 0; dt < 4; ++dt) O[h][dt] = O[h][dt] * al; }
#pragma unroll
            for (int kk = 0; kk < 2; ++kk)
#pragma unroll
                for (int aa = 0; aa < 2; ++aa) s[h][kk][aa] = s[h][kk][aa] - delta;
        }
    }
#pragma unroll
    for (int h = 0; h < 2; ++h) { float ls = 0.f;
#pragma unroll
        for (int kk = 0; kk < 2; ++kk)
#pragma unroll
            for (int aa = 0; aa < 2; ++aa)
#pragma unroll
                for (int j = 0; j < 4; ++j) { const float p = ex2(s[h][kk][aa][j]); s[h][kk][aa][j] = p; ls += p; }
        l[h] += ls; }
    if (vb) pv_tile(vb, s, O, fr, fq);
    }
}
__device__ __forceinline__ void set_cm(float (&cm)[2], const float (&m)[2], float selbase) {
#pragma unroll
    for (int h = 0; h < 2; ++h) cm[h] = selbase - ((m[h] == NEG_INF) ? 0.f : m[h]);
}

#define TILE_PIPE(N, SRC, BODY) do { const int _n = (N); u32x4 _k0, _v0, _k1, _v1; \
    { TileSrc _s; SRC(0, _s); tile_load(_s, tid, _k0, _v0); tile_store(lds, tid, _k0, _v0); } \
    if (_n > 1) { TileSrc _s; SRC(1, _s); tile_load(_s, tid, _k1, _v1); } \
    __syncthreads(); \
    for (int _i = 0; _i < _n; _i += 2) { \
        if (_i + 2 < _n) { TileSrc _s; SRC(_i + 2, _s); tile_load(_s, tid, _k0, _v0); } \
        BODY(_i, lds); \
        if (_i + 1 < _n) tile_store(lds + 16384, tid, _k1, _v1); \
        __syncthreads(); \
        if (_i + 1 >= _n) break; \
        if (_i + 3 < _n) { TileSrc _s; SRC(_i + 3, _s); tile_load(_s, tid, _k1, _v1); } \
        BODY(_i + 1, lds + 16384); \
        if (_i + 2 < _n) tile_store(lds, tid, _k0, _v0); \
        __syncthreads(); \
    } } while (0)

__device__ __forceinline__ void nsa_item(const Args& a, LAS unsigned char* lds, int item, bf16_t* ydst, int ldy) {
    const int tid = threadIdx.x, lane = tid & 63, wave = __builtin_amdgcn_readfirstlane(tid >> 6), fr = lane & 15, fq = lane >> 4;
    unsigned char* ws = a.ws;
    const int qt = 127 - (item >> 3), bg = item & 7, b = bg >> 2, g = bg & 3;
    const int t0 = qt * 64, cur = qt;
    const int qs = wave >> 1, hp = wave & 1, head0 = g * 4 + 2 * hp;
    const int tqi = t0 + 16 * qs + fr; const float tq = (float)tqi;
    const size_t tok = (size_t)b * T_ + tqi;
    const bf16_t* PA = (const bf16_t*)(ws + WS_PA);
    bf16x8 qf[2][2];
#pragma unroll
    for (int h = 0; h < 2; ++h)
#pragma unroll
        for (int ks = 0; ks < 2; ++ks) qf[h][ks] = *(const bf16x8*)(PA + tok * LDPA + PA_Q + (head0 + h) * 64 + 32 * ks + 8 * fq);
    float slope2[2];
#pragma unroll
    for (int h = 0; h < 2; ++h) slope2[h] = ex2(-0.5f * (float)(head0 + h + 1)) * LOG2E;
    const float* smrow = (const float*)(ws + WS_SM) + tok * 64;
    LAS float* IMP = (LAS float*)(lds + NS_IMP);
    LAS unsigned* SELM = (LAS unsigned*)(lds + NS_SELM); LAS unsigned* UNI = (LAS unsigned*)(lds + NS_UNI);
    LAS unsigned char* LIST = lds + NS_LIST; LAS int* NL = (LAS int*)(lds + NS_NL);
    const float BIGW = 1e30f;

    LAS f32x4* OUTS = (LAS f32x4*)(lds + NS_OUTS + wave * 8192) + lane;
    f32x4 O[2][4]; float m[2], l[2];
    __syncthreads();
    if (tid < 4) UNI[tid] = 0u;

    const int ncmp = 4 * qt + 3, nct = (ncmp + 63) >> 6;
    TileSrc cs; cs.k = (const char*)(ws + WS_KC) + (size_t)bg * 512 * 128; cs.v = (const char*)(ws + WS_VCT) + (size_t)bg * 8 * 8192; cs.ks = 128; cs.vs = 128;
    m[0] = m[1] = NEG_INF; l[0] = l[1] = 0.f;
#define CMP_SRC(i, d) do { d = cs; d.k += (size_t)(i) * 8192; d.v += (size_t)(i) * 8192; } while (0)
#define CMP1_SRC(i, d) do { d = cs; d.k += (size_t)(nct - 1 - (i)) * 8192; d.v += (size_t)(nct - 1 - (i)) * 8192; } while (0)
#define CMP1_BODY(ii, buf) do { const int i = nct - 1 - (ii);     \
        f32x4 s[2][2][2]; float cm[2]; set_cm(cm, m, 0.f); \
        bias_tile(s, (float)(1024 * i + 31 + 128 * fq) - tq, 16.f, BIGW, 1024 * i + 1039 > t0, slope2, cm); \
        qk_tile(buf, qf, s, fr, fq); \
        softmax_tile(s, m, l, O, false, (LAS const unsigned char*)0, fr, fq); } while (0)
    TILE_PIPE(nct, CMP1_SRC, CMP1_BODY);
#undef CMP1_BODY
#undef CMP1_SRC
    float mu[2], il[2];
#pragma unroll
    for (int h = 0; h < 2; ++h) { float lt = l[h]; lt += __shfl_xor(lt, 16); lt += __shfl_xor(lt, 32); mu[h] = (m[h] == NEG_INF) ? 0.f : m[h]; il[h] = lt > 0.f ? 1.0f / lt : 0.f; }
    float gcmp[2];
#pragma unroll
    for (int h = 0; h < 2; ++h)
#pragma unroll
        for (int dt = 0; dt < 4; ++dt) O[h][dt] = (f32x4){0.f, 0.f, 0.f, 0.f};
    {
        float prev7 = 0.f;
        LAS float* imp = (hp == 0 ? IMP : (LAS float*)(lds + NS_OUTS)) + (16 * qs + fr) * 128;
        gcmp[0] = smrow[(head0 + 0) * 3 + 0]; gcmp[1] = smrow[(head0 + 1) * 3 + 0];
#define CMP2_BODY(ii, buf) do { const int i = (ii); \
            f32x4 s[2][2][2]; float cm[2]; cm[0] = -mu[0]; cm[1] = -mu[1]; \
            bias_tile(s, (float)(1024 * i + 31 + 128 * fq) - tq, 16.f, BIGW, 1024 * i + 1039 > t0, slope2, cm); \
            qk_tile(buf, qf, s, fr, fq); \
            _Pragma("unroll") for (int h = 0; h < 2; ++h) _Pragma("unroll") for (int kk = 0; kk < 2; ++kk) _Pragma("unroll") for (int aa = 0; aa < 2; ++aa) _Pragma("unroll") for (int j = 0; j < 4; ++j) s[h][kk][aa][j] = ex2(s[h][kk][aa][j]) * il[h]; \
            _Pragma("unroll") for (int kk = 0; kk < 2; ++kk) { \
                float ph[8]; \
                _Pragma("unroll") for (int aa = 0; aa < 2; ++aa) _Pragma("unroll") for (int j = 0; j < 4; ++j) ph[4 * aa + j] = s[0][kk][aa][j] + s[1][kk][aa][j]; \
                const float cin = __shfl((fq == 3) ? prev7 : ph[7], (lane + 48) & 63);     \
                prev7 = ph[7]; \
                f32x2 w; w[0] = 2.f * (ph[0] + ph[1] + ph[2]) + ph[3] + cin; w[1] = 2.f * (ph[4] + ph[5] + ph[6]) + ph[7] + ph[3]; \
                *(LAS f32x2*)(imp + 16 * i + 8 * kk + 2 * fq) = w; \
            } \
            pv_tile(buf + 8192, s, O, fr, fq); } while (0)
        TILE_PIPE(nct, CMP_SRC, CMP2_BODY);
#undef CMP2_BODY
#undef CMP_SRC
    }
    __syncthreads();
#define GSUM8(v) do { v += __builtin_amdgcn_mov_dpp(v, 0xB1, 0xF, 0xF, true); v += __builtin_amdgcn_mov_dpp(v, 0x4E, 0xF, 0xF, true); v += __builtin_amdgcn_mov_dpp(v, 0x141, 0xF, 0xF, true); } while (0)
    {
        const int kg = lane & 7, qq = wave * 8 + (lane >> 3), j0 = kg * 16;
        unsigned key[16];
        {
            const LAS f32x4* src = (const LAS f32x4*)(IMP + qq * 128 + j0); const LAS f32x4* src2 = (const LAS f32x4*)((LAS float*)(lds + NS_OUTS) + qq * 128 + j0);
#pragma unroll
            for (int v4 = 0; v4 < 4; ++v4) { const f32x4 f = src[v4] + src2[v4];
#pragma unroll
                for (int e = 0; e < 4; ++e) { const int j = j0 + 4 * v4 + e; const bool va = j <= cur, fo = (j == 0) || (j == cur) || (j == cur - 1);
                    key[4 * v4 + e] = va ? (fo ? 0x7f800001u : __float_as_uint(f[e]) + 1u) : 0u; } }
        }
        unsigned mask16 = 0u;
        if (cur < 16) {
#pragma unroll
            for (int i = 0; i < 16; ++i) mask16 |= (key[i] != 0u ? 1u : 0u) << i;
        } else {
            unsigned T = 0u; bool done;
            { int cnz = 0;
#pragma unroll
              for (int i = 0; i < 16; ++i) cnz += (key[i] > 1u) ? 1 : 0;
              GSUM8(cnz); done = cnz < 16; if (done) T = 1u; }
#pragma unroll 1
            for (int bit = 30; bit >= 0; --bit) {
                if (__ballot(!done) == 0ull) break;
                const unsigned cand = T | (1u << bit); int c = 0;
#pragma unroll
                for (int i = 0; i < 16; ++i) c += (key[i] >= cand) ? 1 : 0;
                GSUM8(c);
                if (c >= 16 && !done) { T = cand; done = (c == 16); } }
            int gtc = 0, eqc = 0;
#pragma unroll
            for (int i = 0; i < 16; ++i) { gtc += (key[i] > T) ? 1 : 0; eqc += (key[i] == T) ? 1 : 0; }
            GSUM8(gtc);
            const int need = 16 - gtc;
            int incl = eqc;
            { int t = __builtin_amdgcn_mov_dpp(incl, 0x111, 0xF, 0xF, true); if (kg >= 1) incl += t; t = __builtin_amdgcn_mov_dpp(incl, 0x112, 0xF, 0xF, true); if (kg >= 2) incl += t;
              t = __builtin_amdgcn_mov_dpp(incl, 0x114, 0xF, 0xF, true); if (kg >= 4) incl += t; }
            int rank = incl - eqc;
#pragma unroll
            for (int i = 0; i < 16; ++i) { const bool eq = key[i] == T; const bool sel = (key[i] > T) || (eq && rank < need); rank += eq ? 1 : 0; mask16 |= (sel ? 1u : 0u) << i; }
        }
        ((LAS unsigned short*)SELM)[qq * 8 + kg] = (unsigned short)mask16;
        unsigned um = mask16; um |= (unsigned)__shfl_xor((int)um, 8); um |= (unsigned)__shfl_xor((int)um, 16); um |= (unsigned)__shfl_xor((int)um, 32);
        if (lane < 8) ((LAS unsigned short*)(lds + 66816))[wave * 8 + kg] = (unsigned short)um;
    }
#undef GSUM8
    __syncthreads();
    {
        float gc[2];
#pragma unroll
        for (int h = 0; h < 2; ++h) gc[h] = gcmp[h];
#pragma unroll
        for (int h = 0; h < 2; ++h)
#pragma unroll
            for (int dt = 0; dt < 4; ++dt) OUTS[(4 * h + dt) * 64] = O[h][dt] * gc[h];
    }
    if (tid < 64) {
        unsigned w0 = 0u, w1 = 0u, w2 = 0u, w3 = 0u;
#pragma unroll
        for (int w = 0; w < 8; ++w) { const LAS unsigned* uw = (const LAS unsigned*)(lds + 66816) + w * 4; w0 |= uw[0]; w1 |= uw[1]; w2 |= uw[2]; w3 |= uw[3]; }
        const int j0 = lane, j1 = lane + 64;
        const bool in0 = ((j0 < 32 ? w0 >> j0 : w1 >> (j0 - 32)) & 1u) != 0, in1 = ((j0 < 32 ? w2 >> j0 : w3 >> (j0 - 32)) & 1u) != 0;
        const unsigned long long b0 = __ballot(in0), b1 = __ballot(in1);
        const unsigned long long below = (lane == 0) ? 0ull : (~0ull >> (64 - lane));
        const int c0 = __popcll(b0);
        if (in0) LIST[__popcll(b0 & below)] = (unsigned char)j0;
        if (in1) LIST[c0 + __popcll(b1 & below)] = (unsigned char)j1;
        if (lane == 0) *NL = c0 + __popcll(b1);
    }
    __syncthreads();
    {
        const int nl = *NL;
        const unsigned sm0 = SELM[(16 * qs + fr) * 4 + 0], sm1 = SELM[(16 * qs + fr) * 4 + 1], sm2 = SELM[(16 * qs + fr) * 4 + 2], sm3 = SELM[(16 * qs + fr) * 4 + 3];
        m[0] = m[1] = NEG_INF; l[0] = l[1] = 0.f;
#pragma unroll
        for (int h = 0; h < 2; ++h)
#pragma unroll
            for (int dt = 0; dt < 4; ++dt) O[h][dt] = (f32x4){0.f, 0.f, 0.f, 0.f};
        TileSrc ss; ss.k = (const char*)(ws + WS_SKB) + (size_t)(b * 4 + g) * 128 * 8192; ss.v = (const char*)(ws + WS_SVT) + (size_t)(b * 4 + g) * 128 * 8192; ss.ks = 128; ss.vs = 128;
        float gslc[2]; gslc[0] = smrow[(head0 + 0) * 3 + 1]; gslc[1] = smrow[(head0 + 1) * 3 + 1];
#define SLC_SRC(i, d) do { const int jn = LIST[nl - 1 - (i)]; d = ss; d.k += (size_t)jn * 8192; d.v += (size_t)jn * 8192; } while (0)
#define SLC_BODY(ii, buf) do { const int j = LIST[nl - 1 - (ii)]; \
            const unsigned wsel = (j < 32) ? sm0 : (j < 64) ? sm1 : (j < 96) ? sm2 : sm3; \
            const bool sel = ((wsel >> (j & 31)) & 1u) != 0; \
            if (__ballot(sel) != 0ull) { \
                f32x4 s[2][2][2]; float cm[2]; set_cm(cm, m, sel ? 0.f : NEG_INF); \
                bias_tile(s, (float)(64 * j + 8 * fq) - tq, 1.f, BIGW, j == cur, slope2, cm); \
                qk_tile(buf, qf, s, fr, fq); \
                softmax_tile(s, m, l, O, true, buf + 8192, fr, fq); \
            } } while (0)
        TILE_PIPE(nl, SLC_SRC, SLC_BODY);
#undef SLC_BODY
#undef SLC_SRC
#pragma unroll
        for (int h = 0; h < 2; ++h) { float lt = l[h]; lt += __shfl_xor(lt, 16); lt += __shfl_xor(lt, 32);
            const float sc = (lt > 0.f ? 1.0f / lt : 0.f) * gslc[h];
#pragma unroll
            for (int dt = 0; dt < 4; ++dt) OUTS[(4 * h + dt) * 64] = OUTS[(4 * h + dt) * 64] + O[h][dt] * sc; }
    }
    u32x2 zz[2][4];
    {
        m[0] = m[1] = NEG_INF; l[0] = l[1] = 0.f;
#pragma unroll
        for (int h = 0; h < 2; ++h)
#pragma unroll
            for (int dt = 0; dt < 4; ++dt) O[h][dt] = (f32x4){0.f, 0.f, 0.f, 0.f};
        TileSrc ss; ss.k = (const char*)(ws + WS_WKB) + (size_t)(b * 4 + g) * 128 * 8192; ss.v = (const char*)(ws + WS_WVT) + (size_t)(b * 4 + g) * 128 * 8192; ss.ks = 128; ss.vs = 128;
        const int kt0 = (t0 >= 512) ? 0 : (512 - t0) >> 6;
        float gwin[2]; gwin[0] = smrow[(head0 + 0) * 3 + 2]; gwin[1] = smrow[(head0 + 1) * 3 + 2];
#pragma unroll
        for (int h = 0; h < 2; ++h)
#pragma unroll
            for (int dt = 0; dt < 4; ++dt) zz[h][dt] = *(const u32x2*)(PA + tok * LDPA + PA_ZN + (head0 + h) * 64 + 16 * dt + 4 * fq);
#define WIN_SRC(i, d) do { const int jt = qt - 8 + (8 - (i)); d = ss; d.k += (size_t)jt * 8192; d.v += (size_t)jt * 8192; } while (0)
#define WIN_BODY(ii, buf) do { const int kt = 8 - (ii); \
            f32x4 s[2][2][2]; float cm[2]; set_cm(cm, m, 0.f); \
            bias_tile(s, (float)(t0 - 512 + 64 * kt + 8 * fq) - tq, 1.f, 512.f, kt == 0 || kt == 8, slope2, cm); \
            qk_tile(buf, qf, s, fr, fq); \
            softmax_tile(s, m, l, O, true, buf + 8192, fr, fq); } while (0)
        TILE_PIPE(9 - kt0, WIN_SRC, WIN_BODY);
#undef WIN_BODY
#undef WIN_SRC
#pragma unroll
        for (int h = 0; h < 2; ++h) { float lt = l[h]; lt += __shfl_xor(lt, 16); lt += __shfl_xor(lt, 32);
            const float sc = (lt > 0.f ? 1.0f / lt : 0.f) * gwin[h];
#pragma unroll
            for (int dt = 0; dt < 4; ++dt) O[h][dt] = OUTS[(4 * h + dt) * 64] + O[h][dt] * sc; }
    }
#pragma unroll
    for (int h = 0; h < 2; ++h)
#pragma unroll
        for (int dt = 0; dt < 4; ++dt) { const int col = (head0 + h) * 64 + 16 * dt + 4 * fq;
            const u32x2 z = zz[h][dt];
            u32x2 w; w.x = pk2(O[h][dt][0] * bflo(z.x), O[h][dt][1] * bfhi(z.x)); w.y = pk2(O[h][dt][2] * bflo(z.y), O[h][dt][3] * bfhi(z.y));
            *(u32x2*)(ydst + tok * ldy + col) = w; }
}

__device__ __forceinline__ void final_norm(const Args& a, int G, float* dst) {
    const int tid = threadIdx.x, lane = tid & 63, wave = tid >> 6;
    const float* fg = a.in[19]; const bf16_t* dl = (const bf16_t*)(a.ws + WS_PA);
    for (int row = blockIdx.x * 8 + wave; row < NTOK; row += G * 8) {
        const f32x4* xr = (const f32x4*)(a.in[0] + (size_t)row * 2048) + lane; const u32x2* dr = (const u32x2*)(dl + (size_t)row * 2048) + lane;
        f32x4 v[8]; float s = 0.f;
#pragma unroll
        for (int j = 0; j < 8; ++j) { const f32x4 xv = xr[64 * j]; const u32x2 d = dr[64 * j];
            v[j] = (f32x4){xv[0] + bflo(d.x), xv[1] + bfhi(d.x), xv[2] + bflo(d.y), xv[3] + bfhi(d.y)};
            s += (v[j][0] * v[j][0] + v[j][1] * v[j][1]) + (v[j][2] * v[j][2] + v[j][3] * v[j][3]); }
        const float rstd = 1.0f / sqrtf(wave_sum(s) * (1.f / 2048.f) + EPS_);
        f32x4* d = (f32x4*)(dst + (size_t)row * 2048) + lane;
#pragma unroll
        for (int j = 0; j < 8; ++j) { const f32x4 g = *((const f32x4*)fg + lane + 64 * j); d[64 * j] = v[j] * rstd * g; }
    }
}

#define XB_TMO      128
#define XB_XCNT(j)  (256  + 64 * (j))
#define XB_XSUB(j)  (1280 + 64 * (j))
#define XB_XGEN(j)  (2304 + 64 * (j))
#define XB_TOP      3328
#define XB_TOPGEN   3392
#define XCD_BAR_WORDS 3456
#define XB_SPIN_CAP (1u << 18)
__device__ __forceinline__ unsigned xb_ld(unsigned* p)              { return __hip_atomic_load(p, __ATOMIC_RELAXED, __HIP_MEMORY_SCOPE_AGENT); }
__device__ __forceinline__ unsigned xb_add(unsigned* p, unsigned v) { return __hip_atomic_fetch_add(p, v, __ATOMIC_RELAXED, __HIP_MEMORY_SCOPE_AGENT); }
__device__ __forceinline__ unsigned xb_xcc_id() { return (unsigned)__builtin_amdgcn_s_getreg((3 << 11) | 20) & 0xFu; }
#define XB_SPIN(cond, bar) do { unsigned _sp = 0; while (cond) { __builtin_amdgcn_s_sleep(1); \
    if ((++_sp & 255u) == 0u) { if (xb_ld(&(bar)[XB_TMO])) break; if (_sp > XB_SPIN_CAP) { atomicAdd(&(bar)[XB_TMO], 1u); break; } } } } while (0)
__device__ __forceinline__ void xcd_barrier_complete(unsigned* bar, unsigned x, unsigned& nloc, unsigned& nx) {
    const unsigned G = gridDim.x;
    unsigned sum, cnt, mine, sp = 0u;
    for (;;) {
        sum = 0u; cnt = 0u; mine = 0u;
#pragma unroll
        for (unsigned j = 0; j < 16; ++j) { const unsigned c = xb_ld(&bar[XB_XCNT(j)]); sum += c; cnt += (c > 0u) ? 1u : 0u; mine = (j == x) ? c : mine; }
        if (sum == G) break;
        __builtin_amdgcn_s_sleep(1);
        if ((++sp & 255u) == 0u) { if (xb_ld(&bar[XB_TMO])) break; if (sp > XB_SPIN_CAP) { atomicAdd(&bar[XB_TMO], 1u); break; } }
    }
    nloc = mine > 0u ? mine : 1u; nx = cnt > 0u ? cnt : 1u;
}
__device__ __forceinline__ void xcd_barrier(unsigned* bar, volatile LAS unsigned* st) {
    asm volatile("s_waitcnt vmcnt(0)" ::: "memory");
    __syncthreads();
    if (threadIdx.x == 0) {
        const unsigned x = xb_xcc_id();
        __builtin_amdgcn_s_waitcnt(0);
        unsigned nloc = st[0], nx = st[1];
        if (nloc == 0u) { xcd_barrier_complete(bar, x, nloc, nx); st[0] = nloc; st[1] = nx; }
        const unsigned old = xb_add(&bar[XB_XSUB(x)], 1u);
        const unsigned gen = old / nloc;
        if (old + 1u == (gen + 1u) * nloc) {
            __builtin_amdgcn_fence(__ATOMIC_RELEASE, "agent");
            asm volatile("s_waitcnt vmcnt(0)" ::: "memory");
            const unsigned og = xb_add(&bar[XB_TOP], 1u);
            const unsigned tg = og / nx;
            if (og + 1u == (tg + 1u) * nx) xb_add(&bar[XB_TOPGEN], 1u);
            else XB_SPIN(xb_ld(&bar[XB_TOPGEN]) == tg, bar);
            __builtin_amdgcn_fence(__ATOMIC_ACQUIRE, "agent");
            xb_add(&bar[XB_XGEN(x)], 1u);
            asm volatile("s_waitcnt vmcnt(0)" ::: "memory");
        } else {
            XB_SPIN(xb_ld(&bar[XB_XGEN(x)]) == gen, bar);
            __builtin_amdgcn_fence(__ATOMIC_ACQUIRE, "agent");
            asm volatile("s_waitcnt vmcnt(0)" ::: "memory");
        }
    }
    __syncthreads();
}

typedef const __attribute__((address_space(4))) Args* KArgPtr;
__device__ __forceinline__ Args load_args() {
    Args r{};
#if defined(__HIP_DEVICE_COMPILE__)
    KArgPtr p = (KArgPtr)__builtin_amdgcn_kernarg_segment_ptr(); asm volatile("" : "+s"(p));
#pragma unroll
    for (int i = 0; i < 20; ++i) r.in[i] = p->in[i];
    r.out = p->out; r.ws = p->ws; r.ph_lo = p->ph_lo; r.ph_hi = p->ph_hi;
#endif
    return r;
}
__global__ void __launch_bounds__(512, 2) mk_fwd(Args ka) {
    extern __shared__ __attribute__((aligned(16))) unsigned char lds_raw[];
    LAS unsigned char* lds = (LAS unsigned char*)lds_raw;
    cg::grid_group grid = cg::this_grid();
    const int lo = ka.ph_lo, hi = ka.ph_hi, G = gridDim.x, bid = blockIdx.x;
    const int tid = threadIdx.x, lane = tid & 63, wave = tid >> 6;
#ifndef PH_MASK
#define PH_MASK 0x1ff
#endif
#define IN(k) (((PH_MASK >> (k)) & 1) && lo <= (k) && (k) < hi)
#if MK_CG_SYNC
#define SEAM(k) do { if (IN(k) && IN((k) + 1)) grid.sync(); } while (0)
#else
#define SEAM(k) do { if (IN(k) && IN((k) + 1)) xcd_barrier((unsigned*)(ka.ws + WS_CTL), (volatile LAS unsigned*)(lds + LDS_XB)); } while (0)
    if (hi - lo > 1) {
        if (tid == 0) { ((volatile LAS unsigned*)(lds + LDS_XB))[0] = 0u; ((volatile LAS unsigned*)(lds + LDS_XB))[1] = 0u; (void)xb_add((unsigned*)(ka.ws + WS_CTL) + XB_XCNT(xb_xcc_id()), 1u); }
        __syncthreads();
    }
    if (lo > 1000) grid.sync();
#endif
    if (IN(0)) { const Args a = load_args(); p0_phase(a, lds, G);
#if PROBE_DUP & 1
        __syncthreads(); p0_phase(a, lds, G);
#endif
    }
    SEAM(0);
    if (IN(1)) { const Args a = load_args(); p1_phase(a, lds, G);
#if PROBE_DUP & 2
        __syncthreads(); p1_phase(a, lds, G);
#endif
    }
    SEAM(1);
    if (IN(2)) { const Args a = load_args(); OpIn op; op.ws = a.ws; op.lda = 4096; op.ldb = 4096; op.akstep = 128; op.nt = 32; pg8::gemm_phase<OpIn, true>(lds, op, G, bid);
#if PROBE_DUP & 4
        pg8::gemm_phase<OpIn, true>(lds, op, G, bid);
#endif
    }
    SEAM(2);
    if (IN(3)) {
        const Args a = load_args();
        { OpCmp op; op.ws = a.ws; op.lda = 16 * LDPA * 2; op.ldb = 4096; op.akstep = LDPA * 2; op.nt = 32; pg8::gemm_phase<OpCmp, true>(lds, op, G, bid); }
        const int first = (G > 64) ? ((bid >= 32) ? bid - 32 : bid + G - 32) : bid;
#if MK_ONE_LAUNCH
        {
            unsigned* qa = (unsigned*)(a.ws + WS_CTL) + 3600 + 128; volatile LAS unsigned* slot = (volatile LAS unsigned*)(lds + LDS_XB + 8);
            for (;;) { __syncthreads(); if (tid == 0) *slot = __hip_atomic_fetch_add(qa, 1u, __ATOMIC_RELAXED, __HIP_MEMORY_SCOPE_AGENT); __syncthreads();
                const int it = (int)*slot; if (it >= 1024) break; gla_pass_a(a, lds, it); }
        }
#else
        for (int it = first; it < 1024; it += G) gla_pass_a(a, lds, it);
#endif
#if PROBE_DUP & 8
        __syncthreads();
        { OpCmp op; op.ws = a.ws; op.lda = 16 * LDPA * 2; op.ldb = 4096; op.akstep = LDPA * 2; op.nt = 32; pg8::gemm_phase<OpCmp, true>(lds, op, G, bid); }
        for (int it = first; it < 1024; it += G) gla_pass_a(a, lds, it);
#endif
    }
    SEAM(3);
    if (IN(4)) {
        const Args a = load_args();
        for (int it = bid * 8 + wave; it < 512; it += G * 8) cmp2_item(a, it, lane);
#if PROBE_DUP & 16
        for (int it = bid * 8 + wave; it < 512; it += G * 8) cmp2_item(a, it, lane);
        gla_scan(a, G, true);
#endif
        gla_scan(a, G, false);
    }
    SEAM(4);
    if (IN(5)) {
        const Args a = load_args();
#ifndef PROBE_DUP_P5
#define PROBE_DUP_P5 0
#endif
#if MK_ONE_LAUNCH
        {
            unsigned* qn = (unsigned*)(a.ws + WS_CTL) + 3600; unsigned* qg = qn + 64;
            volatile LAS unsigned* slot = (volatile LAS unsigned*)(lds + LDS_XB + 8);
            for (;;) { __syncthreads(); if (tid == 0) *slot = __hip_atomic_fetch_add(qn, 1u, __ATOMIC_RELAXED, __HIP_MEMORY_SCOPE_AGENT); __syncthreads();
                const int it = (int)*slot; if (it >= 1024) break; nsa_item(a, lds, it, (bf16_t*)(a.ws + WS_PA) + PA_Q, LDPA); }
            for (;;) { __syncthreads(); if (tid == 0) *slot = __hip_atomic_fetch_add(qg, 1u, __ATOMIC_RELAXED, __HIP_MEMORY_SCOPE_AGENT); __syncthreads();
                const int it = (int)*slot; if (it >= 1024) break; gla_pass_c(a, lds, it, (bf16_t*)(a.ws + WS_PA) + PA_ZG, LDPA); }
        }
#else
        for (int r = 0; r * G < 1024; ++r) { const int it = r * G + ((r & 1) ? G - 1 - bid : bid); if (it < 1024) nsa_item(a, lds, it, (bf16_t*)(a.ws + WS_PA) + PA_Q, LDPA); }
        for (int it = bid; it < 1024; it += G) gla_pass_c(a, lds, it, (bf16_t*)(a.ws + WS_PA) + PA_ZG, LDPA);
#endif
        __syncthreads();
    }
    SEAM(5);
    if (IN(6)) { const Args a = load_args(); OpMerge op; op.ws = a.ws; op.lda = LDPA * 2; op.ldb = 4096; op.akstep = 128; op.nt = 16; pg8::gemm_phase<OpMerge, true>(lds, op, G, bid);
#if PROBE_DUP & 64
        pg8::gemm_phase<OpMerge, true>(lds, op, G, bid);
#endif
    }
    SEAM(6);
    if (IN(7)) { const Args a = load_args(); OpOut op; op.ws = a.ws; op.x = a.in[0]; op.out = a.out; op.lda = 4096; op.ldb = 4096; op.akstep = 128; op.nt = 32; pg8::gemm_phase<OpOut, true>(lds, op, G, bid);
#if PROBE_DUP & 128
        pg8::gemm_phase<OpOut, true>(lds, op, G, bid);
#endif
    }
    SEAM(7);
#ifdef PROBE_SYNC
    if (IN(7) && IN(8)) { for (int i = 0; i < PROBE_SYNC; ++i) xcd_barrier((unsigned*)(ka.ws + WS_CTL), (volatile LAS unsigned*)(lds + LDS_XB)); }
#endif
    if (IN(8)) { const Args a = load_args();
#if PROBE_DUP & 256
        final_norm(a, G, (float*)(a.ws + WS_PA));
#endif
        final_norm(a, G, a.out); }
#ifdef DBG
    if (lo == 9) {
        const Args a = load_args(); unsigned char* ws = a.ws;
        for (size_t i = (size_t)bid * 512 + tid; i < (size_t)NTOK * DM; i += (size_t)G * 512) {
            float v = 0.f;
#if DBG == 1
            v += bf2f(((const bf16_t*)(ws + WS_PA))[i % ((size_t)NTOK * LDPA)]) + bf2f(((const bf16_t*)(ws + WS_PA))[(i + 33554432) % ((size_t)NTOK * LDPA)]) + bf2f(((const bf16_t*)(ws + WS_PA))[(i + 50331648) % ((size_t)NTOK * LDPA)]);
            v += bf2f(((const bf16_t*)(ws + WS_PB))[i]) + bf2f(((const bf16_t*)(ws + WS_PB))[i + 33554432]);
            v += ((const float*)(ws + WS_SM))[i % (16384 * 64)];
            v += bf2f(((const bf16_t*)(ws + WS_SVT))[i % (2 * 256 * 8192)]) + bf2f(((const bf16_t*)(ws + WS_WVT))[i % (2 * 256 * 8192)]) + bf2f(((const bf16_t*)(ws + WS_GVT))[i % (2 * 1024 * 8192)]);
#elif DBG == 2
            v += bf2f(((const bf16_t*)(ws + WS_KC))[i % (8 * 512 * 64)]) + bf2f(((const bf16_t*)(ws + WS_VCT))[i % (8 * 512 * 64)]) + bf2f(((const bf16_t*)(ws + WS_HB))[i]) + ((const float*)(ws + WS_GAM))[i % (8 * 128 * 128)];
#elif DBG == 5
            v += bf2f(((const bf16_t*)(ws + WS_KC))[i % (8 * 512 * 64)]) + bf2f(((const bf16_t*)(ws + WS_VCT))[i % (8 * 512 * 64)]) + bf2f(((const bf16_t*)(ws + WS_HID))[i % (2 * 4096 * 256)]);
#elif DBG == 6 || DBG == 7
            v += bf2f(((const bf16_t*)(ws + WS_HB))[i]) + ((const float*)(ws + WS_GAM))[i % (8 * 128 * 128)];
#elif DBG == 8
            v += ((const float*)(ws + WS_GAM))[i % (8 * 128 * 128)];
#elif DBG == 3
            v += bf2f(((const bf16_t*)(ws + WS_PA))[(i / 2048) * LDPA + (i % 2048 < 1024 ? i % 1024 : 4096 + i % 1024)]);
#elif DBG == 4
            v += bf2f(((const bf16_t*)(ws + WS_HB))[i]);
#endif
            a.out[i] = v;
        }
    }
#endif
}

extern "C" void kernel_launch(void* const* d_in, const int* in_sizes, int n_in, void* d_out, int out_size, void* d_ws, size_t ws_size, hipStream_t stream) {
    static int grid = 0;
    if (grid == 0) {
        if (n_in != 20 || out_size != NTOK * DM || ws_size < WS_END) { fprintf(stderr, "kernel_launch: unexpected problem (n_in %d out %d ws %zu need %zu)\n", n_in, out_size, ws_size, (size_t)WS_END); grid = -1; return; }
        int dev = 0, cus = 0, per_cu = 0;
        hipGetDevice(&dev); hipDeviceGetAttribute(&cus, hipDeviceAttributeMultiprocessorCount, dev);
        if (hipFuncSetAttribute((const void*)mk_fwd, hipFuncAttributeMaxDynamicSharedMemorySize, LDS_BYTES) != hipSuccess) { fprintf(stderr, "kernel_launch: hipFuncSetAttribute failed\n"); grid = -1; return; }
        if (hipOccupancyMaxActiveBlocksPerMultiprocessor(&per_cu, (const void*)mk_fwd, 512, LDS_BYTES) != hipSuccess || per_cu < 1) { fprintf(stderr, "kernel_launch: occupancy query failed (%d)\n", per_cu); per_cu = 1; }
        (void)hipGetLastError();
        grid = cus * per_cu;
        fprintf(stderr, "kernel_launch: grid %d (cus %d x %d)\n", grid, cus, per_cu);
    }
    if (grid < 0) return;
    Args a{};
    for (int i = 0; i < 20; ++i) a.in[i] = (const float*)d_in[i];
    a.out = (float*)d_out; a.ws = (unsigned char*)d_ws;
#if MK_ONE_LAUNCH
    a.ph_lo = 0; a.ph_hi = 9;
    if (hipMemsetAsync((char*)d_ws + WS_CTL, 0, 16384, stream) != hipSuccess) { fprintf(stderr, "kernel_launch: memset of the barrier words failed\n"); return; }
    void* args[] = {&a};
    hipError_t e = hipLaunchCooperativeKernel((const void*)mk_fwd, dim3(grid), dim3(512), args, LDS_BYTES, stream);
    if (e != hipSuccess) fprintf(stderr, "cooperative launch failed: %s (grid %d)\n", hipGetErrorString(e), grid);
#else
#ifdef DBG
    const int plast = (DBG == 7 || DBG == 8) ? 4 : (DBG == 1) ? 3 : (DBG == 2 || DBG == 5 || DBG == 6) ? 5 : (DBG == 3) ? 6 : 7;
    for (int p = 0; p < plast; ++p) { a.ph_lo = p; a.ph_hi = p + 1; hipLaunchKernelGGL(mk_fwd, dim3(grid), dim3(512), LDS_BYTES, stream, a); }
    a.ph_lo = 9; a.ph_hi = 10; hipLaunchKernelGGL(mk_fwd, dim3(grid), dim3(512), LDS_BYTES, stream, a);
#else
    for (int p = 0; p < 9; ++p) { a.ph_lo = p; a.ph_hi = p + 1; hipLaunchKernelGGL(mk_fwd, dim3(grid), dim3(512), LDS_BYTES, stream, a); }
#endif
#endif
}
```

```cpp
#include <hip/hip_runtime.h>
#include <hip/hip_cooperative_groups.h>
#include <cstdio>
#include <cstdint>
namespace cg = cooperative_groups;

#ifndef PROBE_DUP
#define PROBE_DUP 0
#endif
#ifndef MK_CG_SYNC
#define MK_CG_SYNC 0
#endif
#ifndef MK_ONE_LAUNCH
#define MK_ONE_LAUNCH 1
#endif

#define LAS __attribute__((address_space(3)))
typedef unsigned short bf16_t;
typedef short bf16x8 __attribute__((ext_vector_type(8)));
typedef float f32x4 __attribute__((ext_vector_type(4)));
typedef float f32x2 __attribute__((ext_vector_type(2)));
typedef unsigned u32x4 __attribute__((ext_vector_type(4)));
typedef unsigned u32x2 __attribute__((ext_vector_type(2)));

constexpr int T_ = 8192, DM = 2048, NTOK = 16384;
constexpr int NP = 11008, NREAL = 10816;
constexpr int LDPA = 5120, LDPB = 4096;
constexpr int PA_Q = 0, PA_CK = 1024, PA_CV = 1280, PA_SK = 1536, PA_WK = 1792, PA_ZN = 2048, PA_GQ = 3072, PA_GK = 3584, PA_ZG = 4096;
constexpr float LOG2E = 1.4426950408889634f, LN2 = 0.6931471805599453f;
constexpr float QSCALE = 0.125f * LOG2E;
constexpr float EPS_ = 1e-6f;
constexpr int LDS_BYTES = 133376;
constexpr int LDS_XB = 133120;

constexpr size_t al256(size_t x) { return (x + 255) & ~(size_t)255; }
constexpr size_t WS_CTL = 0;
constexpr size_t WS_APART = 16384;
constexpr size_t WS_GATE = WS_APART + al256(32ull * 2 * 6144 * 4);
constexpr size_t WS_BIASP = WS_GATE + al256(2ull * 2048 * 4);
constexpr size_t WS_CB1P = WS_BIASP + al256(11008ull * 4);
constexpr size_t WS_GAM = WS_CB1P + al256(2ull * 8 * 256 * 4);
constexpr size_t WS_SSQ = WS_GAM + al256(8ull * 128 * 128 * 4);
constexpr size_t WS_W2T = WS_SSQ + al256(16384ull * 32 * 4);
constexpr size_t WS_KC = WS_W2T + al256(2ull * 64 * 256 * 2);
constexpr size_t WS_VCT = WS_KC + al256(8ull * 512 * 64 * 2);
constexpr size_t WS_HID = WS_VCT + al256(8ull * 64 * 512 * 2);
constexpr size_t WS_W1T = WS_HID + al256(2ull * 4096 * 256 * 2);
constexpr size_t WS_WTBR = WS_W1T + al256(2ull * 256 * 2048 * 2);
constexpr size_t WS_WTOUT = WS_WTBR + al256(2048ull * 2048 * 2);
constexpr size_t WS_WTIN = WS_WTOUT + al256(2048ull * 2048 * 2);
constexpr size_t WS_SM = WS_WTIN + al256(11008ull * 2048 * 2);
constexpr size_t WS_SVT = WS_SM + al256(16384ull * 64 * 4);
constexpr size_t WS_WVT = WS_SVT + al256(2ull * 256 * 8192 * 2);
constexpr size_t WS_GVT = WS_WVT + al256(2ull * 256 * 8192 * 2);
constexpr size_t WS_HB = WS_GVT + al256(2ull * 1024 * 8192 * 2);
constexpr size_t WS_PA = WS_HB + al256(16384ull * 2048 * 2);
constexpr size_t WS_PB = WS_PA + al256(16384ull * 5120 * 2);
constexpr size_t WS_SKB = WS_PB + al256(16384ull * 4096 * 2);
constexpr size_t WS_WKB = WS_SKB + al256(2ull * 4 * 8192 * 64 * 2);
constexpr size_t WS_END = WS_WKB + al256(2ull * 4 * 8192 * 64 * 2);
static_assert(WS_END <= 512ull * 1024 * 1024, "workspace");

struct Args { const float* in[20]; float* out; unsigned char* ws; int ph_lo, ph_hi; };

typedef __bf16 bf16x2_t __attribute__((ext_vector_type(2)));
__device__ __forceinline__ unsigned pk2(float lo, float hi) { f32x2 v = {lo, hi}; bf16x2_t b = __builtin_convertvector(v, bf16x2_t); return __builtin_bit_cast(unsigned, b); }
__device__ __forceinline__ float bf2f(unsigned short v) { return __uint_as_float(((unsigned)v) << 16); }
__device__ __forceinline__ float bflo(unsigned v) { return __uint_as_float(v << 16); }
__device__ __forceinline__ float bfhi(unsigned v) { return __uint_as_float(v & 0xffff0000u); }
__device__ __forceinline__ float ex2(float x) { return __builtin_amdgcn_exp2f(x); }
__device__ __forceinline__ float fexp(float x) { return __builtin_amdgcn_exp2f(x * LOG2E); }
__device__ __forceinline__ float sigmoidf_(float x) { return __builtin_amdgcn_rcpf(1.f + fexp(-x)); }
__device__ __forceinline__ float siluf_(float x) { return x * sigmoidf_(x); }
__device__ __forceinline__ float wave_sum(float v) {
#pragma unroll
    for (int o = 1; o < 64; o <<= 1) v += __shfl_xor(v, o);
    return v;
}
#define LDS_WAIT() asm volatile("s_waitcnt lgkmcnt(0)" ::: "memory")
__device__ __forceinline__ bf16x8 as_bf16x8(u32x4 v) { union { u32x4 u; bf16x8 b; } x; x.u = v; return x.b; }

namespace pg8 {
constexpr int BM = 256, BK = 64, HALF = 128, HTB = HALF * BK * 2, STAGE_BYTES = 8 * HTB;
__device__ __forceinline__ int lds_byte(int r, int c) { const int st = (r >> 4) * 2 + (c >> 5), rr = r & 15, cc = c & 31, ob = rr * 64 + cc * 2; return st * 1024 + (ob ^ (((ob >> 9) & 1) << 5)); }
__device__ __forceinline__ void stage_rc(int b, int& R, int& C) { const int st = b / 1024, sb = b % 1024, swz = sb ^ (((sb >> 9) & 1) << 5); R = (st >> 1) * 16 + swz / 64; C = (st & 1) * 32 + (swz % 64) / 2; }
__device__ __forceinline__ int perm32(int rho) { const int n = rho >> 4, i = rho & 15; return 8 * (i >> 2) + 4 * n + (i & 3); }
struct Unit { int pm, pn, sub; };

template <class Op, bool SP2, bool ALIGN_EPI = true>
__device__ __forceinline__ void gemm_phase(LAS unsigned char* lds, const Op& O, const int G, const int c) {
    const int tid = threadIdx.x, wid = __builtin_amdgcn_readfirstlane(tid >> 6), lane = tid & 63, wr = wid >> 2, wc = wid & 3, fr = lane & 15, fq = lane >> 4;
    const int nt = O.nt;
    Unit cur, nxt; int ui = 0;
    if (!O.get(0, c, G, cur)) return;
    unsigned voffA[2], voffB[2];
#pragma unroll
    for (int i = 0; i < 2; ++i) { const int bb = tid * 16 + i * 8192; const int R = bb >> 7; const int C = ((((bb >> 4) & 7) ^ ((R >> 1) & 7)) << 3); const int Rb = Op::PERM ? ((R & ~31) + perm32(R & 31)) : R;
        voffA[i] = (unsigned)R * O.lda + (unsigned)C * 2u; voffB[i] = (unsigned)Rb * O.ldb + (unsigned)C * 2u; }
    const size_t kstepA = (size_t)O.akstep, kstepB = (size_t)(BK * 2);
    const size_t hstepA = (size_t)HALF * O.lda, hstepB = (size_t)HALF * O.ldb;
    const unsigned ldsw = (unsigned)wid * 1024u;
    int aoffk[2], boffk[2];
#pragma unroll
    for (int k = 0; k < 2; ++k) { const int pc = ((k * 4 + fq) ^ ((fr >> 1) & 7)) << 4; aoffk[k] = (wr * 64 + fr) * 128 + pc; boffk[k] = (wc * 32 + fr) * 128 + pc; }
#define PG8_SA(b, h) (((b) * 2 + (h)) * HTB)
#define PG8_SB(b, h) ((4 + (b) * 2 + (h)) * HTB)
#define PG8_STAGE(bufoff, gbase, voff) do { _Pragma("unroll") for (int _i = 0; _i < 2; ++_i) \
        __builtin_amdgcn_global_load_lds((const unsigned*)((const char*)(gbase) + (voff)[_i]), (LAS unsigned*)(lds + (bufoff) + ldsw + _i * 8192), 16, 0, 0); } while (0)
#define PG8_LDA(dst, b, h) do { _Pragma("unroll") for (int m = 0; m < 4; ++m) _Pragma("unroll") for (int k = 0; k < 2; ++k) dst[m][k] = *(const LAS bf16x8*)(lds + PG8_SA(b, h) + aoffk[k] + m * 2048); } while (0)
#define PG8_LDB(dst, b, h) do { _Pragma("unroll") for (int n = 0; n < 2; ++n) _Pragma("unroll") for (int k = 0; k < 2; ++k) dst[n][k] = *(const LAS bf16x8*)(lds + PG8_SB(b, h) + boffk[k] + n * 2048); } while (0)
#define PG8_MMA(ai, bj, At, Bt) do { __builtin_amdgcn_s_setprio(1); _Pragma("unroll") for (int m = 0; m < 4; ++m) _Pragma("unroll") for (int n = 0; n < 2; ++n) _Pragma("unroll") for (int k = 0; k < 2; ++k) \
        acc[ai][bj][m][n] = __builtin_amdgcn_mfma_f32_16x16x32_bf16(Bt[n][k], At[m][k], acc[ai][bj][m][n], 0, 0, 0); __builtin_amdgcn_s_setprio(0); } while (0)
#define PG8_WAIT_V(n) asm volatile("s_waitcnt vmcnt(" #n ")" ::: "memory")
#define PG8_WAIT_L(n) asm volatile("s_waitcnt lgkmcnt(" #n ")" ::: "memory")
#define PG8_BAR __builtin_amdgcn_s_barrier()
#define PG8_SCHED __builtin_amdgcn_sched_barrier(0)
    f32x4 acc[2][2][4][2];
#pragma unroll
    for (int a = 0; a < 2; ++a)
#pragma unroll
        for (int b = 0; b < 2; ++b)
#pragma unroll
            for (int m = 0; m < 4; ++m)
#pragma unroll
                for (int n = 0; n < 2; ++n) acc[a][b][m][n] = (f32x4){0.f, 0.f, 0.f, 0.f};
    bf16x8 At[4][2], B0[2][2], B1[2][2];
    const char* cA = O.a_ptr(cur); const char* cB = O.b_ptr(cur);
#define PG8_BIAS(u, slot) do { if constexpr (Op::LDS_BIAS) { if (wid < 4) __builtin_amdgcn_global_load_lds((const unsigned*)(O.bias_ptr(u) + wid * 64 + lane), (LAS unsigned*)(lds + STAGE_BYTES + (slot) * 1024 + wid * 256), 4, 0, 0); } } while (0)
    PG8_BIAS(cur, 0);
    if constexpr (SP2) {
        PG8_STAGE(PG8_SB(0, 0), cB, voffB); PG8_STAGE(PG8_SB(0, 1), cB + hstepB, voffB); PG8_STAGE(PG8_SA(0, 0), cA, voffA); PG8_STAGE(PG8_SA(0, 1), cA + hstepA, voffA);
        if (wr == 1) PG8_BAR;
        PG8_WAIT_V(2); PG8_BAR;
        PG8_STAGE(PG8_SB(1, 0), cB + kstepB, voffB); PG8_STAGE(PG8_SA(1, 0), cA + kstepA, voffA); PG8_STAGE(PG8_SB(1, 1), cB + hstepB + kstepB, voffB);
        PG8_WAIT_V(6); PG8_BAR;
    } else {
        PG8_STAGE(PG8_SB(0, 0), cB, voffB); PG8_STAGE(PG8_SA(0, 0), cA, voffA); PG8_STAGE(PG8_SB(0, 1), cB + hstepB, voffB); PG8_STAGE(PG8_SA(0, 1), cA + hstepA, voffA);
        if (wr == 1) PG8_BAR;
        PG8_WAIT_V(4); PG8_BAR;
        PG8_STAGE(PG8_SB(1, 0), cB + kstepB, voffB); PG8_STAGE(PG8_SA(1, 0), cA + kstepA, voffA); PG8_STAGE(PG8_SB(1, 1), cB + hstepB + kstepB, voffB);
        PG8_WAIT_V(6); PG8_BAR;
    }
    for (;;) {
        const bool has_next = O.get(ui + 1, c, G, nxt);
        const char* nA = has_next ? O.a_ptr(nxt) : cA; const char* nB = has_next ? O.b_ptr(nxt) : cB;
        for (int t = 0; t < nt; t += 2) {
            const bool last = (t == nt - 2);
            const char* a1 = cA + (size_t)(t + 1) * kstepA;
            const char* a2 = last ? nA : cA + (size_t)(t + 2) * kstepA; const char* b2 = last ? nB : cB + (size_t)(t + 2) * kstepB;
            const char* a3 = a2 + kstepA; const char* b3 = b2 + kstepB;
            if constexpr (SP2) {
            PG8_LDB(B0, 0, 0); PG8_LDB(B1, 0, 1); PG8_SCHED; PG8_LDA(At, 0, 0); PG8_STAGE(PG8_SA(1, 1), a1 + hstepA, voffA);
            PG8_WAIT_V(8); PG8_WAIT_L(0); PG8_BAR; PG8_MMA(0, 0, At, B0); PG8_MMA(0, 1, At, B1); PG8_BAR; PG8_SCHED;
            PG8_LDA(At, 0, 1); PG8_STAGE(PG8_SB(0, 0), b2, voffB); PG8_STAGE(PG8_SB(0, 1), b2 + hstepB, voffB); PG8_STAGE(PG8_SA(0, 0), a2, voffA);
            PG8_WAIT_V(8); PG8_WAIT_L(0); PG8_BAR; PG8_MMA(1, 0, At, B0); PG8_MMA(1, 1, At, B1); PG8_BAR; PG8_SCHED;
            PG8_LDB(B0, 1, 0); PG8_LDB(B1, 1, 1); PG8_SCHED; PG8_LDA(At, 1, 0); PG8_STAGE(PG8_SA(0, 1), a2 + hstepA, voffA);
            PG8_WAIT_V(8); PG8_WAIT_L(0); PG8_BAR; PG8_MMA(0, 0, At, B0); PG8_MMA(0, 1, At, B1); PG8_BAR; PG8_SCHED;
            PG8_LDA(At, 1, 1); PG8_STAGE(PG8_SB(1, 0), b3, voffB); PG8_STAGE(PG8_SB(1, 1), b3 + hstepB, voffB); PG8_STAGE(PG8_SA(1, 0), a3, voffA);
            PG8_WAIT_V(8); PG8_WAIT_L(0); PG8_BAR; PG8_MMA(1, 0, At, B0); PG8_MMA(1, 1, At, B1); PG8_BAR; PG8_SCHED;
            } else {
            PG8_LDB(B0, 0, 0); PG8_SCHED; PG8_LDA(At, 0, 0); PG8_STAGE(PG8_SA(1, 1), a1 + hstepA, voffA);
            PG8_WAIT_L(8); PG8_BAR; PG8_WAIT_L(0); PG8_MMA(0, 0, At, B0); PG8_BAR; PG8_SCHED;
            PG8_LDB(B1, 0, 1); PG8_STAGE(PG8_SB(0, 0), b2, voffB);
            PG8_BAR; PG8_WAIT_L(0); PG8_MMA(0, 1, At, B1); PG8_BAR;
            PG8_LDA(At, 0, 1); PG8_STAGE(PG8_SA(0, 0), a2, voffA);
            PG8_BAR; PG8_WAIT_L(0); PG8_MMA(1, 0, At, B0); PG8_BAR; PG8_SCHED;
            PG8_STAGE(PG8_SB(0, 1), b2 + hstepB, voffB);
            PG8_WAIT_V(6); PG8_BAR; PG8_MMA(1, 1, At, B1); PG8_BAR;
            PG8_LDB(B0, 1, 0); PG8_SCHED; PG8_LDA(At, 1, 0); PG8_STAGE(PG8_SA(0, 1), a2 + hstepA, voffA);
            PG8_WAIT_L(8); PG8_BAR; PG8_WAIT_L(0); PG8_MMA(0, 0, At, B0); PG8_BAR; PG8_SCHED;
            PG8_LDB(B1, 1, 1); PG8_STAGE(PG8_SB(1, 0), b3, voffB);
            PG8_BAR; PG8_WAIT_L(0); PG8_MMA(0, 1, At, B1); PG8_BAR;
            PG8_LDA(At, 1, 1); PG8_STAGE(PG8_SA(1, 0), a3, voffA);
            PG8_BAR; PG8_WAIT_L(0); PG8_MMA(1, 0, At, B0); PG8_BAR; PG8_SCHED;
            PG8_STAGE(PG8_SB(1, 1), b3 + hstepB, voffB);
            PG8_WAIT_V(6); PG8_BAR; PG8_MMA(1, 1, At, B1); PG8_BAR;
            }
        }
        if constexpr (ALIGN_EPI) { if (wr == 0) PG8_BAR; }
        O.epi(acc, cur, wr, wc, fr, fq, (const LAS float*)(lds + STAGE_BYTES + (ui & 1) * 1024));
        if (!has_next) break;
        if (!O.keep(cur)) {
#pragma unroll
        for (int a = 0; a < 2; ++a)
#pragma unroll
            for (int b = 0; b < 2; ++b)
#pragma unroll
                for (int m = 0; m < 4; ++m)
#pragma unroll
                    for (int n = 0; n < 2; ++n) acc[a][b][m][n] = (f32x4){0.f, 0.f, 0.f, 0.f};
        }
        cur = nxt; cA = nA; cB = nB; ++ui;
        PG8_BIAS(cur, ui & 1);
        if constexpr (ALIGN_EPI) { if (wr == 1) PG8_BAR; }
    }
    PG8_WAIT_V(0);
    if constexpr (!ALIGN_EPI) { if (wr == 0) PG8_BAR; }
    PG8_BAR;
#undef PG8_BIAS
#undef PG8_SA
#undef PG8_SB
#undef PG8_STAGE
#undef PG8_LDA
#undef PG8_LDB
#undef PG8_MMA
#undef PG8_WAIT_V
#undef PG8_WAIT_L
#undef PG8_BAR
#undef PG8_SCHED
}
}
using pg8::Unit;

template <int WGM = 8>
__device__ __forceinline__ void tile_order(int L, int nM, int nN, int& pm, int& pn) {
    const int nwg = nM * nN; int wgid = L;
    { const int q = nwg / 8, r = nwg % 8, xcd = wgid % 8, off = wgid / 8; wgid = (xcd < r ? xcd * (q + 1) : r * (q + 1) + (xcd - r) * q) + off; }
    const int nig = WGM * nN, gid = wgid / nig, fm = gid * WGM, gsz = (nM - fm) < WGM ? (nM - fm) : WGM;
    pm = fm + ((wgid % nig) % gsz); pn = (wgid % nig) / gsz;
}

struct OpIn {
    static constexpr bool PERM = true, LDS_BIAS = true;
    __device__ __forceinline__ const float* bias_ptr(const Unit& u) const { return (const float*)(ws + WS_BIASP) + u.pn * 256; }
    unsigned char* ws; unsigned lda, ldb, akstep; int nt;
    __device__ __forceinline__ bool get(int ui, int c, int G, Unit& u) const { const int L = ui * G + c; if (L >= 64 * 43) return false; tile_order<4>(L, 64, 43, u.pm, u.pn); u.sub = 0; return true; }
    __device__ __forceinline__ const char* a_ptr(const Unit& u) const { return (const char*)(ws + WS_HB) + (size_t)u.pm * 256 * lda; }
    __device__ __forceinline__ const char* b_ptr(const Unit& u) const { return (const char*)(ws + WS_WTIN) + (size_t)u.pn * 256 * ldb; }
    __device__ __forceinline__ bool keep(const Unit&) const { return false; }
    __device__ __forceinline__ void epi(f32x4 (&acc)[2][2][4][2], const Unit& u, int wr, int wc, int fr, int fq, const LAS float* lb) const {
        const int pn = u.pn;
        const int row0 = u.pm * 256 + wr * 64 + fr;
        const int ct0 = wc * 32 + 8 * fq;
        f32x4 bv[2][2];
#pragma unroll
        for (int bj = 0; bj < 2; ++bj)
#pragma unroll
            for (int n = 0; n < 2; ++n) bv[bj][n] = *(const LAS f32x4*)(lb + ct0 + bj * 128 + 4 * n);
        int mode = 0;
        bf16_t* base = nullptr; int ld = LDPA; int tbase = 0;
        int trows = 256; bool tiled = false;
        if (pn < 4) { mode = 1; base = (bf16_t*)(ws + WS_PA) + PA_Q + pn * 256; }
        else if (pn == 4) { base = (bf16_t*)(ws + WS_PA) + PA_CK; }
        else if (pn == 5) { base = (bf16_t*)(ws + WS_PA) + PA_CV; }
        else if (pn == 6) { mode = 6; base = (bf16_t*)(ws + WS_SKB); }
        else if (pn == 7) { mode = 4; base = (bf16_t*)(ws + WS_SVT); trows = 256; tbase = 0; tiled = true; }
        else if (pn == 8) { mode = 6; base = (bf16_t*)(ws + WS_WKB); }
        else if (pn == 9) { mode = 4; base = (bf16_t*)(ws + WS_WVT); trows = 256; tbase = 0; tiled = true; }
        else if (pn < 14) { mode = 2; base = (bf16_t*)(ws + WS_PA) + PA_ZN + (pn - 10) * 256; }
        else if (pn < 16) { base = (bf16_t*)(ws + WS_PA) + PA_GQ + (pn - 14) * 256; }
        else if (pn < 18) { base = (bf16_t*)(ws + WS_PA) + PA_GK + (pn - 16) * 256; }
        else if (pn < 22) { mode = 4; base = (bf16_t*)(ws + WS_GVT); trows = 1024; tbase = (pn - 18) * 256; }
        else if (pn < 26) { mode = 2; base = (bf16_t*)(ws + WS_PA) + PA_ZG + (pn - 22) * 256; }
        else if (pn < 42) { mode = 3; base = (bf16_t*)(ws + WS_PB) + (pn - 26) * 256; ld = LDPB; }
        else { mode = 5; }
        if (mode <= 3) {
#pragma unroll
            for (int ai = 0; ai < 2; ++ai)
#pragma unroll
                for (int m = 0; m < 4; ++m) { bf16_t* rowp = base + (size_t)(row0 + ai * 128 + m * 16) * ld + ct0;
#pragma unroll
                    for (int bj = 0; bj < 2; ++bj) { f32x4 v0 = acc[ai][bj][m][0] + bv[bj][0], v1 = acc[ai][bj][m][1] + bv[bj][1];
                        if (mode == 1) { v0 = v0 * QSCALE; v1 = v1 * QSCALE; }
                        else if (mode == 2) {
#pragma unroll
                            for (int e = 0; e < 4; ++e) { v0[e] = siluf_(v0[e]); v1[e] = siluf_(v1[e]); } }
                        else if (mode == 3) {
#pragma unroll
                            for (int e = 0; e < 4; ++e) { v0[e] = sigmoidf_(v0[e]); v1[e] = sigmoidf_(v1[e]); } }
                        u32x4 w; w.x = pk2(v0[0], v0[1]); w.y = pk2(v0[2], v0[3]); w.z = pk2(v1[0], v1[1]); w.w = pk2(v1[2], v1[3]);
                        *(u32x4*)(rowp + bj * 128) = w; } }
        } else if (mode == 6) {
#pragma unroll
            for (int ai = 0; ai < 2; ++ai)
#pragma unroll
                for (int m = 0; m < 4; ++m) { const int row = row0 + ai * 128 + m * 16; const int b = row >> 13, t = row & 8191;
#pragma unroll
                    for (int bj = 0; bj < 2; ++bj) { const int c = ct0 + bj * 128; const f32x4 v0 = acc[ai][bj][m][0] + bv[bj][0], v1 = acc[ai][bj][m][1] + bv[bj][1];
                        u32x4 w; w.x = pk2(v0[0], v0[1]); w.y = pk2(v0[2], v0[3]); w.z = pk2(v1[0], v1[1]); w.w = pk2(v1[2], v1[3]);
                        *(u32x4*)(base + ((size_t)((b * 4 + (c >> 6)) * T_ + t)) * 64 + (c & 63)) = w; } }
        } else if (mode == 4) {
#pragma unroll
            for (int ai = 0; ai < 2; ++ai)
#pragma unroll
                for (int m = 0; m < 4; ++m) { const int row = row0 + ai * 128 + m * 16; const int b = row >> 13, t = row & 8191;
                    bf16_t* colp = base + ((size_t)(b * trows + tbase + ct0)) * T_ + t;
#pragma unroll
                    for (int bj = 0; bj < 2; ++bj)
#pragma unroll
                        for (int n = 0; n < 2; ++n) { const f32x4 v = acc[ai][bj][m][n] + bv[bj][n];
#pragma unroll
                            for (int e = 0; e < 4; ++e) { const unsigned p = pk2(v[e], 0.f);
                                if (tiled) { const int c = ct0 + bj * 128 + 4 * n + e;
                                    base[((size_t)(((b * 4 + (c >> 6)) * 128 + (t >> 6)) * 64 + (c & 63))) * 64 + (t & 63)] = (bf16_t)(p & 0xffffu); }
                                else colp[(size_t)(bj * 128 + 4 * n + e) * T_] = (bf16_t)(p & 0xffffu); } } }
        } else {
            if (wc < 2) {
                float* sm = (float*)(ws + WS_SM);
#pragma unroll
                for (int ai = 0; ai < 2; ++ai)
#pragma unroll
                    for (int m = 0; m < 4; ++m) { const int row = row0 + ai * 128 + m * 16;
#pragma unroll
                        for (int n = 0; n < 2; ++n) { f32x4 v = acc[ai][0][m][n] + bv[0][n]; const int c0 = ct0 + 4 * n;
                            if (c0 < 48) {
#pragma unroll
                                for (int e = 0; e < 4; ++e) v[e] = sigmoidf_(v[e]); }
                            *(f32x4*)(sm + (size_t)row * 64 + c0) = v; } }
            }
        }
    }
};

struct OpCmp {
    static constexpr bool PERM = true, LDS_BIAS = true;
    __device__ __forceinline__ const float* bias_ptr(const Unit& u) const { return (const float*)(ws + WS_SSQ) + u.sub * 256; }
    unsigned char* ws; unsigned lda, ldb, akstep; int nt;
    __device__ __forceinline__ bool get(int ui, int c, int G, Unit& u) const { const int L = ui * G + c; if (L >= 32) return false; u.pm = L & 15; u.pn = 0; u.sub = L >> 4; return true; }
    __device__ __forceinline__ const char* a_ptr(const Unit& u) const {
        const int bg = u.pm >> 1, n0 = (u.pm & 1) * 256, b = bg >> 2, g = bg & 3;
        return (const char*)(ws + WS_PA) + ((size_t)(b * T_ + 16 * n0) * LDPA + (u.sub ? PA_CV : PA_CK) + g * 64) * 2; }
    __device__ __forceinline__ const char* b_ptr(const Unit& u) const { return (const char*)(ws + WS_W1T) + (size_t)u.sub * 256 * 2048 * 2; }
    __device__ __forceinline__ bool keep(const Unit&) const { return false; }
    __device__ __forceinline__ void epi(f32x4 (&acc)[2][2][4][2], const Unit& u, int wr, int wc, int fr, int fq, const LAS float* lb) const {
        const int row0 = u.pm * 256 + wr * 64 + fr, ct0 = wc * 32 + 8 * fq;
        bf16_t* hid = (bf16_t*)(ws + WS_HID) + (size_t)u.sub * 4096 * 256;
        f32x4 bv[2][2];
#pragma unroll
        for (int bj = 0; bj < 2; ++bj)
#pragma unroll
            for (int n = 0; n < 2; ++n) bv[bj][n] = *(const LAS f32x4*)(lb + ct0 + bj * 128 + 4 * n);
#pragma unroll
        for (int ai = 0; ai < 2; ++ai)
#pragma unroll
            for (int m = 0; m < 4; ++m) { bf16_t* rowp = hid + (size_t)(row0 + ai * 128 + m * 16) * 256 + ct0;
#pragma unroll
                for (int bj = 0; bj < 2; ++bj) { f32x4 v0 = acc[ai][bj][m][0] + bv[bj][0], v1 = acc[ai][bj][m][1] + bv[bj][1];
#pragma unroll
                    for (int e = 0; e < 4; ++e) { v0[e] = siluf_(v0[e]); v1[e] = siluf_(v1[e]); }
                    u32x4 w; w.x = pk2(v0[0], v0[1]); w.y = pk2(v0[2], v0[3]); w.z = pk2(v1[0], v1[1]); w.w = pk2(v1[2], v1[3]);
                    *(u32x4*)(rowp + bj * 128) = w; } }
    }
};

struct OpMerge {
    static constexpr bool PERM = true, LDS_BIAS = false;
    __device__ __forceinline__ const float* bias_ptr(const Unit&) const { return nullptr; }
    unsigned char* ws; unsigned lda, ldb, akstep; int nt;
    __device__ __forceinline__ bool get(int ui, int c, int G, Unit& u) const { const int L = (ui >> 1) * G + c; if (L >= 64 * 8) return false; tile_order<4>(L, 64, 8, u.pm, u.pn); u.sub = ui & 1; return true; }
    __device__ __forceinline__ const char* a_ptr(const Unit& u) const { return (const char*)(ws + WS_PA) + ((size_t)u.pm * 256 * LDPA + (u.sub ? PA_ZG : PA_Q)) * 2; }
    __device__ __forceinline__ const char* b_ptr(const Unit& u) const { return (const char*)(ws + WS_WTBR) + ((size_t)u.pn * 256 * 2048 + (u.sub ? 1024 : 0)) * 2; }
    __device__ __forceinline__ bool keep(const Unit& u) const { return u.sub == 0; }
    __device__ __forceinline__ void epi(f32x4 (&acc)[2][2][4][2], const Unit& u, int wr, int wc, int fr, int fq, const LAS float* lb) const {
        const int row0 = u.pm * 256 + wr * 64 + fr, col0 = u.pn * 256 + wc * 32 + 8 * fq;
        const bf16_t* pb = (const bf16_t*)(ws + WS_PB);
        bf16_t* mg = (bf16_t*)(ws + WS_HB);
#pragma unroll
        for (int ai = 0; ai < 2; ++ai)
#pragma unroll
            for (int m = 0; m < 4; ++m) { const size_t row = (size_t)(row0 + ai * 128 + m * 16);
#pragma unroll
                for (int bj = 0; bj < 2; ++bj) {
                    const u32x4 s2 = *(const u32x4*)(pb + row * LDPB + 2048 + col0 + bj * 128);
                    if (u.sub == 0) {
                        const u32x4 s1 = *(const u32x4*)(pb + row * LDPB + col0 + bj * 128);
                        f32x4& v0 = acc[ai][bj][m][0]; f32x4& v1 = acc[ai][bj][m][1];
                        v0[0] *= bflo(s1.x) * __builtin_amdgcn_rcpf(bflo(s2.x)); v0[1] *= bfhi(s1.x) * __builtin_amdgcn_rcpf(bfhi(s2.x));
                        v0[2] *= bflo(s1.y) * __builtin_amdgcn_rcpf(bflo(s2.y)); v0[3] *= bfhi(s1.y) * __builtin_amdgcn_rcpf(bfhi(s2.y));
                        v1[0] *= bflo(s1.z) * __builtin_amdgcn_rcpf(bflo(s2.z)); v1[1] *= bfhi(s1.z) * __builtin_amdgcn_rcpf(bfhi(s2.z));
                        v1[2] *= bflo(s1.w) * __builtin_amdgcn_rcpf(bflo(s2.w)); v1[3] *= bfhi(s1.w) * __builtin_amdgcn_rcpf(bfhi(s2.w));
                    } else {
                        const f32x4 v0 = acc[ai][bj][m][0], v1 = acc[ai][bj][m][1];
                        u32x4 w; w.x = pk2(v0[0] * bflo(s2.x), v0[1] * bfhi(s2.x)); w.y = pk2(v0[2] * bflo(s2.y), v0[3] * bfhi(s2.y));
                        w.z = pk2(v1[0] * bflo(s2.z), v1[1] * bfhi(s2.z)); w.w = pk2(v1[2] * bflo(s2.w), v1[3] * bfhi(s2.w));
                        *(u32x4*)(mg + row * 2048 + col0 + bj * 128) = w;
                    } } }
    }
};

struct OpOut {
    static constexpr bool PERM = true, LDS_BIAS = true;
    __device__ __forceinline__ const float* bias_ptr(const Unit& u) const { return (const float*)(ws + WS_GATE) + ((u.pm * 256) >> 13) * 2048 + u.pn * 256; }
    unsigned char* ws; const float* x; float* out; unsigned lda, ldb, akstep; int nt;
    __device__ __forceinline__ bool get(int ui, int c, int G, Unit& u) const { const int L = ui * G + c; if (L >= 64 * 8) return false; tile_order<4>(L, 64, 8, u.pm, u.pn); u.sub = 0; return true; }
    __device__ __forceinline__ const char* a_ptr(const Unit& u) const { return (const char*)(ws + WS_HB) + (size_t)u.pm * 256 * 2048 * 2; }
    __device__ __forceinline__ const char* b_ptr(const Unit& u) const { return (const char*)(ws + WS_WTOUT) + (size_t)u.pn * 256 * 2048 * 2; }
    __device__ __forceinline__ bool keep(const Unit&) const { return false; }
    __device__ __forceinline__ void epi(f32x4 (&acc)[2][2][4][2], const Unit& u, int wr, int wc, int fr, int fq, const LAS float* lb) const {
        const int row0 = u.pm * 256 + wr * 64 + fr, col0 = u.pn * 256 + wc * 32 + 8 * fq;
        bf16_t* dl = (bf16_t*)(ws + WS_PA);
        const int ct0 = wc * 32 + 8 * fq;
        f32x4 gv[2][2];
#pragma unroll
        for (int bj = 0; bj < 2; ++bj)
#pragma unroll
            for (int n = 0; n < 2; ++n) gv[bj][n] = *(const LAS f32x4*)(lb + ct0 + bj * 128 + 4 * n);
#pragma unroll
        for (int ai = 0; ai < 2; ++ai)
#pragma unroll
            for (int m = 0; m < 4; ++m) { bf16_t* rowp = dl + (size_t)(row0 + ai * 128 + m * 16) * 2048 + col0;
#pragma unroll
                for (int bj = 0; bj < 2; ++bj) { const f32x4 v0 = gv[bj][0] * acc[ai][bj][m][0], v1 = gv[bj][1] * acc[ai][bj][m][1];
                    u32x4 w; w.x = pk2(v0[0], v0[1]); w.y = pk2(v0[2], v0[3]); w.z = pk2(v1[0], v1[1]); w.w = pk2(v1[2], v1[3]);
                    *(u32x4*)(rowp + bj * 128) = w; } }
    }
};

__device__ __forceinline__ void tr_item(const float* src, int ldsrc, int k0, int scol, bf16_t* dst, int lddst, int n0, int kd0, LAS float* scr, int lane) {
    float tv[32];
#pragma unroll
    for (int i = 0; i < 32; ++i) { const int kk = 2 * i + (lane >> 5); tv[i] = scol >= 0 ? src[(size_t)(k0 + kk) * ldsrc + scol] : 0.f; }
#pragma unroll
    for (int i = 0; i < 32; ++i) { const int kk = 2 * i + (lane >> 5); scr[kk * 33 + (lane & 31)] = tv[i]; }
    LDS_WAIT();
    const int c = lane & 7;
#pragma unroll
    for (int j = 0; j < 4; ++j) { const int n = (lane >> 3) + 8 * j; const LAS float* s = scr + (8 * c) * 33 + n;
        u32x4 o; o.x = pk2(s[0 * 33], s[1 * 33]); o.y = pk2(s[2 * 33], s[3 * 33]); o.z = pk2(s[4 * 33], s[5 * 33]); o.w = pk2(s[6 * 33], s[7 * 33]);
        *(u32x4*)(dst + (size_t)(n0 + n) * lddst + kd0 + k0 + 8 * c) = o; }
    LDS_WAIT();
}
__device__ __forceinline__ int in_orig_col(int n) {
    if (n < 2560) return n;
    if (n < 5632) return n + 48;
    if (n < 10752) return n + 64;
    if (n < 10800) return 2560 + (n - 10752);
    if (n < 10816) return 5680 + (n - 10800);
    return -1;
}
__device__ __forceinline__ void p0_phase(const Args& a, LAS unsigned char* lds, int G) {
    const int tid = threadIdx.x, lane = tid & 63, wave = tid >> 6;
    unsigned char* ws = a.ws;
    LAS float* scr = (LAS float*)(lds + wave * 16384);
    const int gw = blockIdx.x * 8 + wave, NGW = G * 8;
    constexpr int I_IN = 32 * 344, I_BR = 16 * 64, I_OUT = 32 * 64, I_W1 = 32 * 8, I_W2 = 4 * 2, I_ADA = 16 * 96, I_BIAS = 172, I_CB = 2 * 4 * 8;
    constexpr int NITEMS = I_IN + 2 * I_BR + I_OUT + 2 * I_W1 + 2 * I_W2 + I_ADA + I_BIAS + I_CB;
    for (int it = gw; it < NITEMS; it += NGW) {
        int r = it;
        if (r < I_IN) { const int kb = r / 344, nb = r % 344; tr_item(a.in[5], NREAL, 64 * kb, in_orig_col(32 * nb + (lane & 31)), (bf16_t*)(ws + WS_WTIN), 2048, 32 * nb, 0, scr, lane); continue; } r -= I_IN;
        if (r < I_BR) { const int kb = r / 64, nb = r % 64; tr_item(a.in[16], 2048, 64 * kb, 32 * nb + (lane & 31), (bf16_t*)(ws + WS_WTBR), 2048, 32 * nb, 0, scr, lane); continue; } r -= I_BR;
        if (r < I_BR) { const int kb = r / 64, nb = r % 64; tr_item(a.in[17], 2048, 64 * kb, 32 * nb + (lane & 31), (bf16_t*)(ws + WS_WTBR), 2048, 32 * nb, 1024, scr, lane); continue; } r -= I_BR;
        if (r < I_OUT) { const int kb = r / 64, nb = r % 64; tr_item(a.in[18], 2048, 64 * kb, 32 * nb + (lane & 31), (bf16_t*)(ws + WS_WTOUT), 2048, 32 * nb, 0, scr, lane); continue; } r -= I_OUT;
        if (r < I_W1) { const int kb = r / 8, nb = r % 8; tr_item(a.in[9], 256, 64 * kb, 32 * nb + (lane & 31), (bf16_t*)(ws + WS_W1T), 2048, 32 * nb, 0, scr, lane); continue; } r -= I_W1;
        if (r < I_W1) { const int kb = r / 8, nb = r % 8; tr_item(a.in[11], 256, 64 * kb, 32 * nb + (lane & 31), (bf16_t*)(ws + WS_W1T) + 256 * 2048, 2048, 32 * nb, 0, scr, lane); continue; } r -= I_W1;
        if (r < I_W2) { const int kb = r / 2, nb = r % 2; tr_item(a.in[10], 64, 64 * kb, 32 * nb + (lane & 31), (bf16_t*)(ws + WS_W2T), 256, 32 * nb, 0, scr, lane); continue; } r -= I_W2;
        if (r < I_W2) { const int kb = r / 2, nb = r % 2; tr_item(a.in[12], 64, 64 * kb, 32 * nb + (lane & 31), (bf16_t*)(ws + WS_W2T) + 64 * 256, 256, 32 * nb, 0, scr, lane); continue; } r -= I_W2;
        if (r < I_ADA) {
            const int kc = r / 96, j = (r % 96) * 64 + lane; const float* w = a.in[2] + (size_t)(kc * 128) * 6144 + j; const float* c0 = a.in[1] + kc * 128; const float* c1 = c0 + 2048;
            float s0 = 0.f, s1 = 0.f;
#pragma unroll 32
            for (int k = 0; k < 128; ++k) { const float wv = w[(size_t)k * 6144]; s0 += c0[k] * wv; s1 += c1[k] * wv; }
            float* ap = (float*)(ws + WS_APART) + (size_t)kc * 2 * 6144; ap[j] = s0; ap[6144 + j] = s1; continue; } r -= I_ADA;
        if (r < I_BIAS) { const int n = r * 64 + lane; const int oc = in_orig_col(n); ((float*)(ws + WS_BIASP))[n] = oc >= 0 ? a.in[6][oc] : 0.f; continue; } r -= I_BIAS;
        {
            const int which = r >> 5, jc = (r >> 3) & 3, kc = r & 7, j = jc * 64 + lane;
            const float* pos = a.in[which ? 8 : 7] + kc * 256; const float* w = a.in[which ? 11 : 9] + (size_t)(kc * 256) * 256 + j; float s = 0.f;
#pragma unroll 8
            for (int k = 0; k < 256; ++k) s += pos[k] * w[(size_t)k * 256];
            ((float*)(ws + WS_CB1P))[which * 2048 + kc * 256 + j] = s; }
    }
}

__device__ __forceinline__ void p1_phase(const Args& a, LAS unsigned char* lds, int G) {
    const int tid = threadIdx.x, lane = tid & 63, wave = tid >> 6;
    unsigned char* ws = a.ws;
    const float* ap = (const float*)(ws + WS_APART);
    const float* bada = a.in[3];
    for (int idx = blockIdx.x * 512 + tid; idx < 4096; idx += G * 512) { const int b = idx >> 11, k = idx & 2047; float s = bada[4096 + k];
        for (int kc = 0; kc < 16; ++kc) s += ap[(size_t)kc * 2 * 6144 + b * 6144 + 4096 + k];
        ((float*)(ws + WS_GATE))[idx] = s; }
    for (int idx = blockIdx.x * 512 + tid; idx < 512; idx += G * 512) { const float* cb = (const float*)(ws + WS_CB1P) + (idx >> 8) * 2048 + (idx & 255); float s = 0.f;
        for (int p = 0; p < 8; ++p) s += cb[p * 256];
        ((float*)(ws + WS_SSQ))[idx] = s; }
    LAS float* gsc = (LAS float*)lds; LAS float* sh = gsc + 2048;
    for (int chunk = blockIdx.x; chunk < 256; chunk += G) {
        const int b = chunk >> 7;
        __syncthreads();
        for (int k = tid; k < 2048; k += 512) { float s0 = bada[k], s1 = bada[2048 + k];
            for (int kc = 0; kc < 16; ++kc) { const float* p = ap + (size_t)kc * 2 * 6144 + b * 6144; s0 += p[k]; s1 += p[2048 + k]; }
            sh[k] = s0; gsc[k] = (1.f + s1) * a.in[4][k]; }
        __syncthreads();
        for (int rr = wave; rr < 64; rr += 16) {
            f32x4 v[2][8]; float s[2] = {0.f, 0.f};
#pragma unroll
            for (int r2 = 0; r2 < 2; ++r2) { const f32x4* xr = (const f32x4*)(a.in[0] + (size_t)(chunk * 64 + rr + 8 * r2) * 2048) + lane;
#pragma unroll
                for (int j = 0; j < 8; ++j) v[r2][j] = xr[64 * j]; }
#pragma unroll
            for (int r2 = 0; r2 < 2; ++r2)
#pragma unroll
                for (int j = 0; j < 8; ++j) s[r2] += (v[r2][j][0] * v[r2][j][0] + v[r2][j][1] * v[r2][j][1]) + (v[r2][j][2] * v[r2][j][2] + v[r2][j][3] * v[r2][j][3]);
#pragma unroll
            for (int r2 = 0; r2 < 2; ++r2) {
                const float rstd = 1.0f / sqrtf(wave_sum(s[r2]) * (1.f / 2048.f) + EPS_);
                u32x2* o = (u32x2*)((bf16_t*)(ws + WS_HB) + (size_t)(chunk * 64 + rr + 8 * r2) * 2048) + lane;
#pragma unroll
                for (int j = 0; j < 8; ++j) { const int k = (lane + 64 * j) * 4; const f32x4 g4 = *(const LAS f32x4*)(gsc + k), s4 = *(const LAS f32x4*)(sh + k);
                    u32x2 w; w.x = pk2(v[r2][j][0] * rstd * g4[0] + s4[0], v[r2][j][1] * rstd * g4[1] + s4[1]); w.y = pk2(v[r2][j][2] * rstd * g4[2] + s4[2], v[r2][j][3] * rstd * g4[3] + s4[3]);
                    o[64 * j] = w; } }
        }
    }
}

constexpr int GL_GA = 32768, GL_TOT = 36864, GL_QP = 40960, GL_KP = 57344, GL_AL = 73728, GL_SSQ = 81920;

__device__ __forceinline__ void gla_cumsum(const Args& a, LAS unsigned char* lds, int b, int h, int c, float (&bv)[16], float& blast) {
    const int tid = threadIdx.x, k = tid & 127, ig = tid >> 7;
    const float* sm = (const float*)(a.ws + WS_SM);
    LAS float* GA = (LAS float*)(lds + GL_GA); LAS float* TOT = (LAS float*)(lds + GL_TOT);
    const int tok0 = b * T_ + c * 64;
    __syncthreads();
    { const int idx = tid * 2, i = idx >> 4, r = idx & 15; const f32x2 v = *(const f32x2*)(sm + (size_t)(tok0 + i) * 64 + 48 + r); GA[idx] = v[0]; GA[idx + 1] = v[1]; }
    float wa[16];
#pragma unroll
    for (int r = 0; r < 16; ++r) wa[r] = a.in[13][r * 512 + h * 128 + k];
    const float ba = a.in[14][h * 128 + k];
    __syncthreads();
    float run = 0.f;
#pragma unroll
    for (int e = 0; e < 16; ++e) { const LAS float* g = GA + (16 * ig + e) * 16; float x = ba;
#pragma unroll
        for (int r = 0; r < 16; ++r) x += g[r] * wa[r];
        const float sp = fmaxf(-x, 0.f) + LN2 * __builtin_amdgcn_logf(1.f + ex2(-fabsf(x) * LOG2E));
        run -= sp * 0.0625f; bv[e] = run; }
    TOT[ig * 128 + k] = run;
    __syncthreads();
    float pre = 0.f, tot = 0.f;
#pragma unroll
    for (int g = 0; g < 4; ++g) { const float t = TOT[g * 128 + k]; if (g < ig) pre += t; tot += t; }
#pragma unroll
    for (int e = 0; e < 16; ++e) bv[e] += pre;
    blast = tot;
}

__device__ __forceinline__ size_t us_off(int bh, int c, int v) { return ((size_t)((bh * 32 + (v >> 3)) * 128 + c) * 8 + (v & 7)) * 128; }
__device__ __forceinline__ void gla_pass_a(const Args& a, LAS unsigned char* lds, int item) {
    const int tid = threadIdx.x, lane = tid & 63, wave = tid >> 6, fr = lane & 15, fq = lane >> 4, k = tid & 127, ig = tid >> 7;
    const int bh = item >> 7, c = item & 127, b = bh >> 2, h = bh & 3;
    unsigned char* ws = a.ws;
    float bv[16], blast;
    gla_cumsum(a, lds, b, h, c, bv, blast);
    if (ig == 0) ((float*)(ws + WS_GAM))[(size_t)(bh * 128 + c) * 128 + k] = fexp(blast);
    LAS unsigned char* KT = lds + GL_QP;
    const bf16_t* gk = (const bf16_t*)(ws + WS_PA) + (size_t)(b * T_ + c * 64 + 16 * ig) * LDPA + PA_GK + h * 128 + k;
    {
        float kv[16];
#pragma unroll
        for (int e = 0; e < 16; ++e) kv[e] = bf2f(gk[(size_t)e * LDPA]) * fexp(blast - bv[e]);
        u32x4 w0, w1; w0.x = pk2(kv[0], kv[1]); w0.y = pk2(kv[2], kv[3]); w0.z = pk2(kv[4], kv[5]); w0.w = pk2(kv[6], kv[7]);
        w1.x = pk2(kv[8], kv[9]); w1.y = pk2(kv[10], kv[11]); w1.z = pk2(kv[12], kv[13]); w1.w = pk2(kv[14], kv[15]);
        *(LAS u32x4*)(KT + k * 128 + (((2 * ig) ^ (k & 7)) << 4)) = w0;
        *(LAS u32x4*)(KT + k * 128 + (((2 * ig + 1) ^ (k & 7)) << 4)) = w1;
    }
    __syncthreads();
    const bf16_t* gvt = (const bf16_t*)(ws + WS_GVT) + (size_t)(b * 1024 + h * 256 + 32 * wave) * T_ + c * 64;
    bf16x8 vf[2][2];
#pragma unroll
    for (int vt = 0; vt < 2; ++vt)
#pragma unroll
        for (int js = 0; js < 2; ++js) vf[vt][js] = *(const bf16x8*)(gvt + (size_t)(16 * vt + fr) * T_ + 32 * js + 8 * fq);
    bf16_t* us = (bf16_t*)(ws + WS_HB);
#pragma unroll
    for (int kt = 0; kt < 8; ++kt) {
        const int kr = 16 * kt + fr;
        const bf16x8 k0 = *(const LAS bf16x8*)(KT + kr * 128 + (((fq) ^ (kr & 7)) << 4));
        const bf16x8 k1 = *(const LAS bf16x8*)(KT + kr * 128 + (((4 + fq) ^ (kr & 7)) << 4));
#pragma unroll
        for (int vt = 0; vt < 2; ++vt) { f32x4 acc = (f32x4){0.f, 0.f, 0.f, 0.f};
            acc = __builtin_amdgcn_mfma_f32_16x16x32_bf16(k0, vf[vt][0], acc, 0, 0, 0);
            acc = __builtin_amdgcn_mfma_f32_16x16x32_bf16(k1, vf[vt][1], acc, 0, 0, 0);
            u32x2 w; w.x = pk2(acc[0], acc[1]); w.y = pk2(acc[2], acc[3]);
            *(u32x2*)(us + us_off(bh, c, 32 * wave + 16 * vt + fr) + 16 * kt + 4 * fq) = w; }
    }
}

__device__ __forceinline__ void gla_scan(const Args& a, int G, bool dummy) {
    unsigned char* ws = a.ws;
    for (int blk = blockIdx.x; blk < 256; blk += G) {
        const int bh = blk >> 5, k2 = (threadIdx.x & 63) * 2;
        unsigned* p = (unsigned*)((bf16_t*)(ws + WS_HB) + (size_t)blk * 128 * 1024 + threadIdx.x * 2);
        const f32x2* gm = (const f32x2*)((const float*)(ws + WS_GAM) + (size_t)bh * 128 * 128 + k2);
        float s0 = 0.f, s1 = 0.f;
#pragma unroll 32
        for (int c = 0; c < 128; ++c) { const unsigned u = p[c * 512]; const f32x2 g = gm[c * 64];
            (dummy ? (unsigned*)(ws + WS_WTIN) + (((size_t)blk * 128 * 512 + threadIdx.x) & 0x7fffffu) : p)[c * 512] = pk2(s0, s1); s0 = g[0] * s0 + bflo(u); s1 = g[1] * s1 + bfhi(u); }
    }
}

__device__ __forceinline__ void gla_pass_c(const Args& a, LAS unsigned char* lds, int item, bf16_t* ydst, int ldy) {
    const int tid = threadIdx.x, lane = tid & 63, wave = tid >> 6, fr = lane & 15, fq = lane >> 4, k = tid & 127, ig = tid >> 7;
    const int bh = item >> 7, c = item & 127, b = bh >> 2, h = bh & 3;
    unsigned char* ws = a.ws;
    float bv[16], blast;
    const int tok0 = b * T_ + c * 64;
    bf16_t qraw[16], kraw[16];
    {
        const bf16_t* gq = (const bf16_t*)(ws + WS_PA) + (size_t)(tok0 + 16 * ig) * LDPA + PA_GQ + h * 128 + k;
        const bf16_t* gk = gq + (PA_GK - PA_GQ);
#pragma unroll
        for (int e = 0; e < 16; ++e) { qraw[e] = gq[(size_t)e * LDPA]; kraw[e] = gk[(size_t)e * LDPA]; }
    }
    gla_cumsum(a, lds, b, h, c, bv, blast);
    LAS unsigned char* QP = lds + GL_QP; LAS unsigned char* KP = lds + GL_KP; LAS unsigned char* AL = lds + GL_AL; LAS float* SSQ = (LAS float*)(lds + GL_SSQ);
    {
        const int ck = k >> 3, ko = (k & 7) * 2;
#pragma unroll
        for (int e = 0; e < 16; ++e) { const int i = 16 * ig + e; const int off = i * 256 + ((ck ^ (i & 7)) << 4) + ko;
            const float qv = bf2f(qraw[e]) * fexp(bv[e]) * 0.08838834764831845f;
            const float kv = bf2f(kraw[e]) * fexp(-bv[e]);
            *(LAS bf16_t*)(QP + off) = (bf16_t)(pk2(qv, 0.f) & 0xffffu); *(LAS bf16_t*)(KP + off) = (bf16_t)(pk2(kv, 0.f) & 0xffffu); }
    }
    __syncthreads();
    {
        const int it = wave >> 1;
#pragma unroll
        for (int q = 0; q < 2; ++q) { const int jt = (wave & 1) * 2 + q; f32x4 acc = (f32x4){0.f, 0.f, 0.f, 0.f};
            if (jt <= it) {
                const int jr = 16 * jt + fr, ir = 16 * it + fr;
#pragma unroll
                for (int ks = 0; ks < 4; ++ks) {
                    const bf16x8 kf = *(const LAS bf16x8*)(KP + jr * 256 + (((4 * ks + fq) ^ (jr & 7)) << 4));
                    const bf16x8 qf = *(const LAS bf16x8*)(QP + ir * 256 + (((4 * ks + fq) ^ (ir & 7)) << 4));
                    acc = __builtin_amdgcn_mfma_f32_16x16x32_bf16(kf, qf, acc, 0, 0, 0); }
            }
            const int i = 16 * it + fr, j0 = 16 * jt + 4 * fq;
#pragma unroll
            for (int jj = 0; jj < 4; ++jj) if (j0 + jj > i) acc[jj] = 0.f;
            u32x2 w; w.x = pk2(acc[0], acc[1]); w.y = pk2(acc[2], acc[3]);
            *(LAS u32x2*)(AL + i * 128 + ((((j0 >> 3)) ^ (i & 7)) << 4) + (fq & 1) * 8) = w; }
    }
    __syncthreads();
    f32x4 o[2][4];
#pragma unroll
    for (int vt = 0; vt < 2; ++vt)
#pragma unroll
        for (int it = 0; it < 4; ++it) o[vt][it] = (f32x4){0.f, 0.f, 0.f, 0.f};
    {
        const bf16_t* gvt = (const bf16_t*)(ws + WS_GVT) + (size_t)(b * 1024 + h * 256 + 32 * wave) * T_ + c * 64;
#pragma unroll
        for (int js = 0; js < 2; ++js) {
            bf16x8 vf[2];
#pragma unroll
            for (int vt = 0; vt < 2; ++vt) vf[vt] = *(const bf16x8*)(gvt + (size_t)(16 * vt + fr) * T_ + 32 * js + 8 * fq);
#pragma unroll
            for (int it = 0; it < 4; ++it) { const int ir = 16 * it + fr;
                const bf16x8 af = *(const LAS bf16x8*)(AL + ir * 128 + (((4 * js + fq) ^ (ir & 7)) << 4));
#pragma unroll
                for (int vt = 0; vt < 2; ++vt) o[vt][it] = __builtin_amdgcn_mfma_f32_16x16x32_bf16(vf[vt], af, o[vt][it], 0, 0, 0); }
        }
        const bf16_t* st = (const bf16_t*)(ws + WS_HB);
#pragma unroll
        for (int ks = 0; ks < 4; ++ks) {
            bf16x8 sf[2];
#pragma unroll
            for (int vt = 0; vt < 2; ++vt) sf[vt] = *(const bf16x8*)(st + us_off(bh, c, 32 * wave + 16 * vt + fr) + 32 * ks + 8 * fq);
#pragma unroll
            for (int it = 0; it < 4; ++it) { const int ir = 16 * it + fr;
                const bf16x8 qf = *(const LAS bf16x8*)(QP + ir * 256 + (((4 * ks + fq) ^ (ir & 7)) << 4));
#pragma unroll
                for (int vt = 0; vt < 2; ++vt) o[vt][it] = __builtin_amdgcn_mfma_f32_16x16x32_bf16(sf[vt], qf, o[vt][it], 0, 0, 0); }
        }
    }
#pragma unroll
    for (int it = 0; it < 4; ++it) { float s = 0.f;
#pragma unroll
        for (int vt = 0; vt < 2; ++vt) s += (o[vt][it][0] * o[vt][it][0] + o[vt][it][1] * o[vt][it][1]) + (o[vt][it][2] * o[vt][it][2] + o[vt][it][3] * o[vt][it][3]);
        s += __shfl_xor(s, 16); s += __shfl_xor(s, 32);
        if (fq == 0) SSQ[wave * 64 + 16 * it + fr] = s; }
    __syncthreads();
    const float* gn = a.in[15];
#pragma unroll
    for (int it = 0; it < 4; ++it) { const int i = 16 * it + fr; float tot = 0.f;
#pragma unroll
        for (int w = 0; w < 8; ++w) tot += SSQ[w * 64 + i];
        const float rstd = 1.0f / sqrtf(tot * (1.f / 256.f) + EPS_);
        bf16_t* zrow = (bf16_t*)(ws + WS_PA) + (size_t)(tok0 + i) * LDPA + PA_ZG + h * 256 + 32 * wave;
#pragma unroll
        for (int vt = 0; vt < 2; ++vt) { const int v0 = 16 * vt + 4 * fq; const u32x2 z = *(const u32x2*)(zrow + v0); const f32x4 g = *(const f32x4*)(gn + 32 * wave + v0);
            u32x2 w; w.x = pk2(o[vt][it][0] * rstd * g[0] * bflo(z.x), o[vt][it][1] * rstd * g[1] * bfhi(z.x));
            w.y = pk2(o[vt][it][2] * rstd * g[2] * bflo(z.y), o[vt][it][3] * rstd * g[3] * bfhi(z.y));
            *(u32x2*)(ydst + (size_t)(tok0 + i) * ldy + h * 256 + 32 * wave + v0) = w; } }
}

__device__ __forceinline__ void cmp2_item(const Args& a, int item, int lane) {
    const int fr = lane & 15, fq = lane >> 4; unsigned char* ws = a.ws;
    const int which = item >> 8, rt = item & 255;
    const bf16_t* hid = (const bf16_t*)(ws + WS_HID) + ((size_t)which * 4096 + rt * 16) * 256;
    const bf16_t* w2t = (const bf16_t*)(ws + WS_W2T) + (size_t)which * 64 * 256;
    f32x4 acc[4];
#pragma unroll
    for (int dt = 0; dt < 4; ++dt) acc[dt] = (f32x4){0.f, 0.f, 0.f, 0.f};
#pragma unroll
    for (int ks = 0; ks < 8; ++ks) {
        const bf16x8 hf = *(const bf16x8*)(hid + (size_t)fr * 256 + 32 * ks + 8 * fq);
#pragma unroll
        for (int dt = 0; dt < 4; ++dt) { const bf16x8 wf = *(const bf16x8*)(w2t + (size_t)(16 * dt + fr) * 256 + 32 * ks + 8 * fq);
            if (which == 0) acc[dt] = __builtin_amdgcn_mfma_f32_16x16x32_bf16(wf, hf, acc[dt], 0, 0, 0);
            else acc[dt] = __builtin_amdgcn_mfma_f32_16x16x32_bf16(hf, wf, acc[dt], 0, 0, 0); }
    }
    const int row = rt * 16, bg = row >> 9, n0 = row & 511;
#pragma unroll
    for (int dt = 0; dt < 4; ++dt) { u32x2 w; w.x = pk2(acc[dt][0], acc[dt][1]); w.y = pk2(acc[dt][2], acc[dt][3]);
        if (which == 0) *(u32x2*)((bf16_t*)(ws + WS_KC) + ((size_t)bg * 512 + n0 + fr) * 64 + 16 * dt + 4 * fq) = w;
        else { const int n = n0 + 4 * fq; *(u32x2*)((bf16_t*)(ws + WS_VCT) + ((size_t)((bg * 8 + (n >> 6)) * 64 + 16 * dt + fr)) * 64 + (n & 63)) = w; } }
}

constexpr int NS_IMP = 32768, NS_SELM = 65536, NS_UNI = 66560, NS_LIST = 66624, NS_NL = 66752, NS_OUTS = 67584;
constexpr float NEG_INF = -__builtin_inff();

struct TileSrc { const char* k; const char* v; size_t ks, vs; };
__device__ __forceinline__ void tile_load(const TileSrc& s, int tid, u32x4& kr, u32x4& vr) {
    const int row = tid >> 3, ch = tid & 7;
    kr = *(const u32x4*)(s.k + (size_t)row * s.ks + ch * 16); vr = *(const u32x4*)(s.v + (size_t)row * s.vs + ch * 16);
}
__device__ __forceinline__ int swz_k(int row) { return ((row >> 3) & 3) | (((row >> 1) & 1) << 2); }
__device__ __forceinline__ int swz_v(int row) { return (row >> 1) & 7; }
__device__ __forceinline__ void tile_store(LAS unsigned char* buf, int tid, const u32x4& kr, const u32x4& vr) {
    const int row = tid >> 3, ch = tid & 7;
    *(LAS u32x4*)(buf + row * 128 + ((ch ^ swz_k(row)) << 4)) = kr; *(LAS u32x4*)(buf + 8192 + row * 128 + ((ch ^ swz_v(row)) << 4)) = vr;
}
__device__ __forceinline__ void qk_tile(LAS const unsigned char* kb, const bf16x8 (&qf)[2][2], f32x4 (&s)[2][2][2], int fr, int fq) {
#pragma unroll
    for (int kk = 0; kk < 2; ++kk)
#pragma unroll
        for (int aa = 0; aa < 2; ++aa) { const int kr = 32 * kk + 8 * (fr >> 2) + 4 * aa + (fr & 3);
            const bf16x8 k0 = *(const LAS bf16x8*)(kb + kr * 128 + (((fq) ^ swz_k(kr)) << 4));
            const bf16x8 k1 = *(const LAS bf16x8*)(kb + kr * 128 + (((4 + fq) ^ swz_k(kr)) << 4));
#pragma unroll
            for (int h = 0; h < 2; ++h) { s[h][kk][aa] = __builtin_amdgcn_mfma_f32_16x16x32_bf16(k0, qf[h][0], s[h][kk][aa], 0, 0, 0);
                s[h][kk][aa] = __builtin_amdgcn_mfma_f32_16x16x32_bf16(k1, qf[h][1], s[h][kk][aa], 0, 0, 0); } }
}
__device__ __forceinline__ void bias_tile(f32x4 (&s)[2][2][2], float d1, float pstride, float win, bool mask, const float (&slope2)[2], const float (&cm)[2]) {
    if (mask) {
#pragma unroll
        for (int kk = 0; kk < 2; ++kk)
#pragma unroll
            for (int aa = 0; aa < 2; ++aa)
#pragma unroll
                for (int j = 0; j < 4; ++j) { const float rel = d1 + pstride * (float)(32 * kk + 4 * aa + j);
                    const bool valid = (rel <= 0.f) && (rel > -win);
                    s[0][kk][aa][j] = valid ? __builtin_fmaf(slope2[0], rel, cm[0]) : NEG_INF; s[1][kk][aa][j] = valid ? __builtin_fmaf(slope2[1], rel, cm[1]) : NEG_INF; }
    } else {
#pragma unroll
        for (int kk = 0; kk < 2; ++kk)
#pragma unroll
            for (int aa = 0; aa < 2; ++aa)
#pragma unroll
                for (int j = 0; j < 4; ++j) { const float rel = d1 + pstride * (float)(32 * kk + 4 * aa + j);
                    s[0][kk][aa][j] = __builtin_fmaf(slope2[0], rel, cm[0]); s[1][kk][aa][j] = __builtin_fmaf(slope2[1], rel, cm[1]); }
    }
}
__device__ __forceinline__ void pv_tile(LAS const unsigned char* vb, const f32x4 (&p)[2][2][2], f32x4 (&O)[2][4], int fr, int fq) {
#pragma unroll
    for (int kk = 0; kk < 2; ++kk) {
        bf16x8 pf[2];
#pragma unroll
        for (int h = 0; h < 2; ++h) { u32x4 w; w.x = pk2(p[h][kk][0][0], p[h][kk][0][1]); w.y = pk2(p[h][kk][0][2], p[h][kk][0][3]); w.z = pk2(p[h][kk][1][0], p[h][kk][1][1]); w.w = pk2(p[h][kk][1][2], p[h][kk][1][3]); pf[h] = as_bf16x8(w); }
#pragma unroll
        for (int dt = 0; dt < 4; ++dt) { const int dr = 16 * dt + fr;
            const bf16x8 vf = *(const LAS bf16x8*)(vb + dr * 128 + (((4 * kk + fq) ^ swz_v(dr)) << 4));
#pragma unroll
            for (int h = 0; h < 2; ++h) O[h][dt] = __builtin_amdgcn_mfma_f32_16x16x32_bf16(vf, pf[h], O[h][dt], 0, 0, 0); }
    }
}
constexpr float SM_THR = 5.0f;
__device__ __forceinline__ void softmax_tile(f32x4 (&s)[2][2][2], float (&m)[2], float (&l)[2], f32x4 (&O)[2][4], bool scaleO, LAS const unsigned char* vb, int fr, int fq) {
    float mx[2]; bool need = false;
#pragma unroll
    for (int h = 0; h < 2; ++h) {
        float v = NEG_INF;
#pragma unroll
        for (int kk = 0; kk < 2; ++kk)
#pragma unroll
            for (int aa = 0; aa < 2; ++aa) v = fmaxf(v, fmaxf(fmaxf(s[h][kk][aa][0], s[h][kk][aa][1]), fmaxf(s[h][kk][aa][2], s[h][kk][aa][3])));
        mx[h] = v; need = need || ((m[h] == NEG_INF) ? (v > NEG_INF) : (v > SM_THR));
    }
    const unsigned long long needm = __ballot(need);
    if ((needm | __ballot((mx[0] > -150.f) || (mx[1] > -150.f))) != 0ull) {
    if (needm != 0ull) {
#pragma unroll
        for (int h = 0; h < 2; ++h) {
            float q = mx[h]; q = fmaxf(q, __shfl_xor(q, 16)); q = fmaxf(q, __shfl_xor(q, 32));
            const bool unset = (m[h] == NEG_INF);
            const float delta = unset ? ((q == NEG_INF) ? 0.f : q) : fmaxf(q, 0.f);
            const float al = unset ? 1.f : ex2(-delta);
            m[h] = unset ? q : m[h] + delta;
            l[h] *= al;
            if (scaleO) {
#pragma unroll
                for (int dt = 0; dt < 4; ++dt) O[h][dt] = O[h][dt] * al; }
#pragma unroll
            for (int kk = 0; kk < 2; ++kk)
#pragma unroll
                for (int aa = 0; aa < 2; ++aa) s[h][kk][aa] = s[h][kk][aa] - delta;
        }
    }
#pragma unroll
    for (int h = 0; h < 2; ++h) { float ls = 0.f;
#pragma unroll
        for (int kk = 0; kk < 2; ++kk)
#pragma unroll
            for (int aa = 0; aa < 2; ++aa)
#pragma unroll
                for (int j = 0; j < 4; ++j) { const float p = ex2(s[h][kk][aa][j]); s[h][kk][aa][j] = p; ls += p; }
        l[h] += ls; }
    if (vb) pv_tile(vb, s, O, fr, fq);
    }
}
__device__ __forceinline__ void set_cm(float (&cm)[2], const float (&m)[2], float selbase) {
#pragma unroll
    for (int h = 0; h < 2; ++h) cm[h] = selbase - ((m[h] == NEG_INF) ? 0.f : m[h]);
}

#define TILE_PIPE(N, SRC, BODY) do { const int _n = (N); u32x4 _k0, _v0, _k1, _v1; \
    { TileSrc _s; SRC(0, _s); tile_load(_s, tid, _k0, _v0); tile_store(lds, tid, _k0, _v0); } \
    if (_n > 1) { TileSrc _s; SRC(1, _s); tile_load(_s, tid, _k1, _v1); } \
    __syncthreads(); \
    for (int _i = 0; _i < _n; _i += 2) { \
        if (_i + 2 < _n) { TileSrc _s; SRC(_i + 2, _s); tile_load(_s, tid, _k0, _v0); } \
        BODY(_i, lds); \
        if (_i + 1 < _n) tile_store(lds + 16384, tid, _k1, _v1); \
        __syncthreads(); \
        if (_i + 1 >= _n) break; \
        if (_i + 3 < _n) { TileSrc _s; SRC(_i + 3, _s); tile_load(_s, tid, _k1, _v1); } \
        BODY(_i + 1, lds + 16384); \
        if (_i + 2 < _n) tile_store(lds, tid, _k0, _v0); \
        __syncthreads(); \
    } } while (0)

__device__ __forceinline__ void nsa_item(const Args& a, LAS unsigned char* lds, int item, bf16_t* ydst, int ldy) {
    const int tid = threadIdx.x, lane = tid & 63, wave = __builtin_amdgcn_readfirstlane(tid >> 6), fr = lane & 15, fq = lane >> 4;
    unsigned char* ws = a.ws;
    const int qt = 127 - (item >> 3), bg = item & 7, b = bg >> 2, g = bg & 3;
    const int t0 = qt * 64, cur = qt;
    const int qs = wave >> 1, hp = wave & 1, head0 = g * 4 + 2 * hp;
    const int tqi = t0 + 16 * qs + fr; const float tq = (float)tqi;
    const size_t tok = (size_t)b * T_ + tqi;
    const bf16_t* PA = (const bf16_t*)(ws + WS_PA);
    bf16x8 qf[2][2];
#pragma unroll
    for (int h = 0; h < 2; ++h)
#pragma unroll
        for (int ks = 0; ks < 2; ++ks) qf[h][ks] = *(const bf16x8*)(PA + tok * LDPA + PA_Q + (head0 + h) * 64 + 32 * ks + 8 * fq);
    float slope2[2];
#pragma unroll
    for (int h = 0; h < 2; ++h) slope2[h] = ex2(-0.5f * (float)(head0 + h + 1)) * LOG2E;
    const float* smrow = (const float*)(ws + WS_SM) + tok * 64;
    LAS float* IMP = (LAS float*)(lds + NS_IMP);
    LAS unsigned* SELM = (LAS unsigned*)(lds + NS_SELM); LAS unsigned* UNI = (LAS unsigned*)(lds + NS_UNI);
    LAS unsigned char* LIST = lds + NS_LIST; LAS int* NL = (LAS int*)(lds + NS_NL);
    const float BIGW = 1e30f;

    LAS f32x4* OUTS = (LAS f32x4*)(lds + NS_OUTS + wave * 8192) + lane;
    f32x4 O[2][4]; float m[2], l[2];
    __syncthreads();
    if (tid < 4) UNI[tid] = 0u;

    const int ncmp = 4 * qt + 3, nct = (ncmp + 63) >> 6;
    TileSrc cs; cs.k = (const char*)(ws + WS_KC) + (size_t)bg * 512 * 128; cs.v = (const char*)(ws + WS_VCT) + (size_t)bg * 8 * 8192; cs.ks = 128; cs.vs = 128;
    m[0] = m[1] = NEG_INF; l[0] = l[1] = 0.f;
#define CMP_SRC(i, d) do { d = cs; d.k += (size_t)(i) * 8192; d.v += (size_t)(i) * 8192; } while (0)
#define CMP1_SRC(i, d) do { d = cs; d.k += (size_t)(nct - 1 - (i)) * 8192; d.v += (size_t)(nct - 1 - (i)) * 8192; } while (0)
#define CMP1_BODY(ii, buf) do { const int i = nct - 1 - (ii);     \
        f32x4 s[2][2][2]; float cm[2]; set_cm(cm, m, 0.f); \
        bias_tile(s, (float)(1024 * i + 31 + 128 * fq) - tq, 16.f, BIGW, 1024 * i + 1039 > t0, slope2, cm); \
        qk_tile(buf, qf, s, fr, fq); \
        softmax_tile(s, m, l, O, false, (LAS const unsigned char*)0, fr, fq); } while (0)
    TILE_PIPE(nct, CMP1_SRC, CMP1_BODY);
#undef CMP1_BODY
#undef CMP1_SRC
    float mu[2], il[2];
#pragma unroll
    for (int h = 0; h < 2; ++h) { float lt = l[h]; lt += __shfl_xor(lt, 16); lt += __shfl_xor(lt, 32); mu[h] = (m[h] == NEG_INF) ? 0.f : m[h]; il[h] = lt > 0.f ? 1.0f / lt : 0.f; }
    float gcmp[2];
#pragma unroll
    for (int h = 0; h < 2; ++h)
#pragma unroll
        for (int dt = 0; dt < 4; ++dt) O[h][dt] = (f32x4){0.f, 0.f, 0.f, 0.f};
    {
        float prev7 = 0.f;
        LAS float* imp = (hp == 0 ? IMP : (LAS float*)(lds + NS_OUTS)) + (16 * qs + fr) * 128;
        gcmp[0] = smrow[(head0 + 0) * 3 + 0]; gcmp[1] = smrow[(head0 + 1) * 3 + 0];
#define CMP2_BODY(ii, buf) do { const int i = (ii); \
            f32x4 s[2][2][2]; float cm[2]; cm[0] = -mu[0]; cm[1] = -mu[1]; \
            bias_tile(s, (float)(1024 * i + 31 + 128 * fq) - tq, 16.f, BIGW, 1024 * i + 1039 > t0, slope2, cm); \
            qk_tile(buf, qf, s, fr, fq); \
            _Pragma("unroll") for (int h = 0; h < 2; ++h) _Pragma("unroll") for (int kk = 0; kk < 2; ++kk) _Pragma("unroll") for (int aa = 0; aa < 2; ++aa) _Pragma("unroll") for (int j = 0; j < 4; ++j) s[h][kk][aa][j] = ex2(s[h][kk][aa][j]) * il[h]; \
            _Pragma("unroll") for (int kk = 0; kk < 2; ++kk) { \
                float ph[8]; \
                _Pragma("unroll") for (int aa = 0; aa < 2; ++aa) _Pragma("unroll") for (int j = 0; j < 4; ++j) ph[4 * aa + j] = s[0][kk][aa][j] + s[1][kk][aa][j]; \
                const float cin = __shfl((fq == 3) ? prev7 : ph[7], (lane + 48) & 63);     \
                prev7 = ph[7]; \
                f32x2 w; w[0] = 2.f * (ph[0] + ph[1] + ph[2]) + ph[3] + cin; w[1] = 2.f * (ph[4] + ph[5] + ph[6]) + ph[7] + ph[3]; \
                *(LAS f32x2*)(imp + 16 * i + 8 * kk + 2 * fq) = w; \
            } \
            pv_tile(buf + 8192, s, O, fr, fq); } while (0)
        TILE_PIPE(nct, CMP_SRC, CMP2_BODY);
#undef CMP2_BODY
#undef CMP_SRC
    }
    __syncthreads();
#define GSUM8(v) do { v += __builtin_amdgcn_mov_dpp(v, 0xB1, 0xF, 0xF, true); v += __builtin_amdgcn_mov_dpp(v, 0x4E, 0xF, 0xF, true); v += __builtin_amdgcn_mov_dpp(v, 0x141, 0xF, 0xF, true); } while (0)
    {
        const int kg = lane & 7, qq = wave * 8 + (lane >> 3), j0 = kg * 16;
        unsigned key[16];
        {
            const LAS f32x4* src = (const LAS f32x4*)(IMP + qq * 128 + j0); const LAS f32x4* src2 = (const LAS f32x4*)((LAS float*)(lds + NS_OUTS) + qq * 128 + j0);
#pragma unroll
            for (int v4 = 0; v4 < 4; ++v4) { const f32x4 f = src[v4] + src2[v4];
#pragma unroll
                for (int e = 0; e < 4; ++e) { const int j = j0 + 4 * v4 + e; const bool va = j <= cur, fo = (j == 0) || (j == cur) || (j == cur - 1);
                    key[4 * v4 + e] = va ? (fo ? 0x7f800001u : __float_as_uint(f[e]) + 1u) : 0u; } }
        }
        unsigned mask16 = 0u;
        if (cur < 16) {
#pragma unroll
            for (int i = 0; i < 16; ++i) mask16 |= (key[i] != 0u ? 1u : 0u) << i;
        } else {
            unsigned T = 0u; bool done;
            { int cnz = 0;
#pragma unroll
              for (int i = 0; i < 16; ++i) cnz += (key[i] > 1u) ? 1 : 0;
              GSUM8(cnz); done = cnz < 16; if (done) T = 1u; }
#pragma unroll 1
            for (int bit = 30; bit >= 0; --bit) {
                if (__ballot(!done) == 0ull) break;
                const unsigned cand = T | (1u << bit); int c = 0;
#pragma unroll
                for (int i = 0; i < 16; ++i) c += (key[i] >= cand) ? 1 : 0;
                GSUM8(c);
                if (c >= 16 && !done) { T = cand; done = (c == 16); } }
            int gtc = 0, eqc = 0;
#pragma unroll
            for (int i = 0; i < 16; ++i) { gtc += (key[i] > T) ? 1 : 0; eqc += (key[i] == T) ? 1 : 0; }
            GSUM8(gtc);
            const int need = 16 - gtc;
            int incl = eqc;
            { int t = __builtin_amdgcn_mov_dpp(incl, 0x111, 0xF, 0xF, true); if (kg >= 1) incl += t; t = __builtin_amdgcn_mov_dpp(incl, 0x112, 0xF, 0xF, true); if (kg >= 2) incl += t;
              t = __builtin_amdgcn_mov_dpp(incl, 0x114, 0xF, 0xF, true); if (kg >= 4) incl += t; }
            int rank = incl - eqc;
#pragma unroll
            for (int i = 0; i < 16; ++i) { const bool eq = key[i] == T; const bool sel = (key[i] > T) || (eq && rank < need); rank += eq ? 1 : 0; mask16 |= (sel ? 1u : 0u) << i; }
        }
        ((LAS unsigned short*)SELM)[qq * 8 + kg] = (unsigned short)mask16;
        unsigned um = mask16; um |= (unsigned)__shfl_xor((int)um, 8); um |= (unsigned)__shfl_xor((int)um, 16); um |= (unsigned)__shfl_xor((int)um, 32);
        if (lane < 8) ((LAS unsigned short*)(lds + 66816))[wave * 8 + kg] = (unsigned short)um;
    }
#undef GSUM8
    __syncthreads();
    {
        float gc[2];
#pragma unroll
        for (int h = 0; h < 2; ++h) gc[h] = gcmp[h];
#pragma unroll
        for (int h = 0; h < 2; ++h)
#pragma unroll
            for (int dt = 0; dt < 4; ++dt) OUTS[(4 * h + dt) * 64] = O[h][dt] * gc[h];
    }
    if (tid < 64) {
        unsigned w0 = 0u, w1 = 0u, w2 = 0u, w3 = 0u;
#pragma unroll
        for (int w = 0; w < 8; ++w) { const LAS unsigned* uw = (const LAS unsigned*)(lds + 66816) + w * 4; w0 |= uw[0]; w1 |= uw[1]; w2 |= uw[2]; w3 |= uw[3]; }
        const int j0 = lane, j1 = lane + 64;
        const bool in0 = ((j0 < 32 ? w0 >> j0 : w1 >> (j0 - 32)) & 1u) != 0, in1 = ((j0 < 32 ? w2 >> j0 : w3 >> (j0 - 32)) & 1u) != 0;
        const unsigned long long b0 = __ballot(in0), b1 = __ballot(in1);
        const unsigned long long below = (lane == 0) ? 0ull : (~0ull >> (64 - lane));
        const int c0 = __popcll(b0);
        if (in0) LIST[__popcll(b0 & below)] = (unsigned char)j0;
        if (in1) LIST[c0 + __popcll(b1 & below)] = (unsigned char)j1;
        if (lane == 0) *NL = c0 + __popcll(b1);
    }
    __syncthreads();
    {
        const int nl = *NL;
        const unsigned sm0 = SELM[(16 * qs + fr) * 4 + 0], sm1 = SELM[(16 * qs + fr) * 4 + 1], sm2 = SELM[(16 * qs + fr) * 4 + 2], sm3 = SELM[(16 * qs + fr) * 4 + 3];
        m[0] = m[1] = NEG_INF; l[0] = l[1] = 0.f;
#pragma unroll
        for (int h = 0; h < 2; ++h)
#pragma unroll
            for (int dt = 0; dt < 4; ++dt) O[h][dt] = (f32x4){0.f, 0.f, 0.f, 0.f};
        TileSrc ss; ss.k = (const char*)(ws + WS_SKB) + (size_t)(b * 4 + g) * 128 * 8192; ss.v = (const char*)(ws + WS_SVT) + (size_t)(b * 4 + g) * 128 * 8192; ss.ks = 128; ss.vs = 128;
        float gslc[2]; gslc[0] = smrow[(head0 + 0) * 3 + 1]; gslc[1] = smrow[(head0 + 1) * 3 + 1];
#define SLC_SRC(i, d) do { const int jn = LIST[nl - 1 - (i)]; d = ss; d.k += (size_t)jn * 8192; d.v += (size_t)jn * 8192; } while (0)
#define SLC_BODY(ii, buf) do { const int j = LIST[nl - 1 - (ii)]; \
            const unsigned wsel = (j < 32) ? sm0 : (j < 64) ? sm1 : (j < 96) ? sm2 : sm3; \
            const bool sel = ((wsel >> (j & 31)) & 1u) != 0; \
            if (__ballot(sel) != 0ull) { \
                f32x4 s[2][2][2]; float cm[2]; set_cm(cm, m, sel ? 0.f : NEG_INF); \
                bias_tile(s, (float)(64 * j + 8 * fq) - tq, 1.f, BIGW, j == cur, slope2, cm); \
                qk_tile(buf, qf, s, fr, fq); \
                softmax_tile(s, m, l, O, true, buf + 8192, fr, fq); \
            } } while (0)
        TILE_PIPE(nl, SLC_SRC, SLC_BODY);
#undef SLC_BODY
#undef SLC_SRC
#pragma unroll
        for (int h = 0; h < 2; ++h) { float lt = l[h]; lt += __shfl_xor(lt, 16); lt += __shfl_xor(lt, 32);
            const float sc = (lt > 0.f ? 1.0f / lt : 0.f) * gslc[h];
#pragma unroll
            for (int dt = 0; dt < 4; ++dt) OUTS[(4 * h + dt) * 64] = OUTS[(4 * h + dt) * 64] + O[h][dt] * sc; }
    }
    u32x2 zz[2][4];
    {
        m[0] = m[1] = NEG_INF; l[0] = l[1] = 0.f;
#pragma unroll
        for (int h = 0; h < 2; ++h)
#pragma unroll
            for (int dt = 0; dt < 4; ++dt) O[h][dt] = (f32x4){0.f, 0.f, 0.f, 0.f};
        TileSrc ss; ss.k = (const char*)(ws + WS_WKB) + (size_t)(b * 4 + g) * 128 * 8192; ss.v = (const char*)(ws + WS_WVT) + (size_t)(b * 4 + g) * 128 * 8192; ss.ks = 128; ss.vs = 128;
        const int kt0 = (t0 >= 512) ? 0 : (512 - t0) >> 6;
        float gwin[2]; gwin[0] = smrow[(head0 + 0) * 3 + 2]; gwin[1] = smrow[(head0 + 1) * 3 + 2];
#pragma unroll
        for (int h = 0; h < 2; ++h)
#pragma unroll
            for (int dt = 0; dt < 4; ++dt) zz[h][dt] = *(const u32x2*)(PA + tok * LDPA + PA_ZN + (head0 + h) * 64 + 16 * dt + 4 * fq);
#define WIN_SRC(i, d) do { const int jt = qt - 8 + (8 - (i)); d = ss; d.k += (size_t)jt * 8192; d.v += (size_t)jt * 8192; } while (0)
#define WIN_BODY(ii, buf) do { const int kt = 8 - (ii); \
            f32x4 s[2][2][2]; float cm[2]; set_cm(cm, m, 0.f); \
            bias_tile(s, (float)(t0 - 512 + 64 * kt + 8 * fq) - tq, 1.f, 512.f, kt == 0 || kt == 8, slope2, cm); \
            qk_tile(buf, qf, s, fr, fq); \
            softmax_tile(s, m, l, O, true, buf + 8192, fr, fq); } while (0)
        TILE_PIPE(9 - kt0, WIN_SRC, WIN_BODY);
#undef WIN_BODY
#undef WIN_SRC
#pragma unroll
        for (int h = 0; h < 2; ++h) { float lt = l[h]; lt += __shfl_xor(lt, 16); lt += __shfl_xor(lt, 32);
            const float sc = (lt > 0.f ? 1.0f / lt : 0.f) * gwin[h];
#pragma unroll
            for (int dt = 0; dt < 4; ++dt) O[h][dt] = OUTS[(4 * h + dt) * 64] + O[h][dt] * sc; }
    }
#pragma unroll
    for (int h = 0; h < 2; ++h)
#pragma unroll
        for (int dt = 0; dt < 4; ++dt) { const int col = (head0 + h) * 64 + 16 * dt + 4 * fq;
            const u32x2 z = zz[h][dt];
            u32x2 w; w.x = pk2(O[h][dt][0] * bflo(z.x), O[h][dt][1] * bfhi(z.x)); w.y = pk2(O[h][dt][2] * bflo(z.y), O[h][dt][3] * bfhi(z.y));
            *(u32x2*)(ydst + tok * ldy + col) = w; }
}

__device__ __forceinline__ void final_norm(const Args& a, int G, float* dst) {
    const int tid = threadIdx.x, lane = tid & 63, wave = tid >> 6;
    const float* fg = a.in[19]; const bf16_t* dl = (const bf16_t*)(a.ws + WS_PA);
    for (int row0 = blockIdx.x * 8 + wave; row0 < NTOK; row0 += 2 * G * 8) {
        f32x4 xv[2][8]; u32x2 dv[2][8];
#pragma unroll
        for (int r2 = 0; r2 < 2; ++r2) { const int row = row0 + r2 * G * 8; if (row < NTOK) {
            const f32x4* xr = (const f32x4*)(a.in[0] + (size_t)row * 2048) + lane; const u32x2* dr = (const u32x2*)(dl + (size_t)row * 2048) + lane;
#pragma unroll
            for (int j = 0; j < 8; ++j) { xv[r2][j] = xr[64 * j]; dv[r2][j] = dr[64 * j]; } } }
#pragma unroll
        for (int r2 = 0; r2 < 2; ++r2) { const int row = row0 + r2 * G * 8; if (row < NTOK) {
            f32x4 v[8]; float s = 0.f;
#pragma unroll
            for (int j = 0; j < 8; ++j) { const u32x2 d = dv[r2][j];
                v[j] = (f32x4){xv[r2][j][0] + bflo(d.x), xv[r2][j][1] + bfhi(d.x), xv[r2][j][2] + bflo(d.y), xv[r2][j][3] + bfhi(d.y)};
                s += (v[j][0] * v[j][0] + v[j][1] * v[j][1]) + (v[j][2] * v[j][2] + v[j][3] * v[j][3]); }
            const float rstd = 1.0f / sqrtf(wave_sum(s) * (1.f / 2048.f) + EPS_);
            f32x4* d = (f32x4*)(dst + (size_t)row * 2048) + lane;
#pragma unroll
            for (int j = 0; j < 8; ++j) { const f32x4 g = *((const f32x4*)fg + lane + 64 * j); d[64 * j] = v[j] * rstd * g; } } }
    }
}

#define XB_TMO      128
#define XB_XCNT(j)  (256  + 64 * (j))
#define XB_XSUB(j)  (1280 + 64 * (j))
#define XB_XGEN(j)  (2304 + 64 * (j))
#define XB_TOP      3328
#define XB_TOPGEN   3392
#define XCD_BAR_WORDS 3456
#define XB_SPIN_CAP (1u << 18)
__device__ __forceinline__ unsigned xb_ld(unsigned* p)              { return __hip_atomic_load(p, __ATOMIC_RELAXED, __HIP_MEMORY_SCOPE_AGENT); }
__device__ __forceinline__ unsigned xb_add(unsigned* p, unsigned v) { return __hip_atomic_fetch_add(p, v, __ATOMIC_RELAXED, __HIP_MEMORY_SCOPE_AGENT); }
__device__ __forceinline__ unsigned xb_xcc_id() { return (unsigned)__builtin_amdgcn_s_getreg((3 << 11) | 20) & 0xFu; }
#define XB_SPIN(cond, bar) do { unsigned _sp = 0; while (cond) { __builtin_amdgcn_s_sleep(1); \
    if ((++_sp & 255u) == 0u) { if (xb_ld(&(bar)[XB_TMO])) break; if (_sp > XB_SPIN_CAP) { atomicAdd(&(bar)[XB_TMO], 1u); break; } } } } while (0)
__device__ __forceinline__ void xcd_barrier_complete(unsigned* bar, unsigned x, unsigned& nloc, unsigned& nx) {
    const unsigned G = gridDim.x;
    unsigned sum, cnt, mine, sp = 0u;
    for (;;) {
        sum = 0u; cnt = 0u; mine = 0u;
#pragma unroll
        for (unsigned j = 0; j < 16; ++j) { const unsigned c = xb_ld(&bar[XB_XCNT(j)]); sum += c; cnt += (c > 0u) ? 1u : 0u; mine = (j == x) ? c : mine; }
        if (sum == G) break;
        __builtin_amdgcn_s_sleep(1);
        if ((++sp & 255u) == 0u) { if (xb_ld(&bar[XB_TMO])) break; if (sp > XB_SPIN_CAP) { atomicAdd(&bar[XB_TMO], 1u); break; } }
    }
    nloc = mine > 0u ? mine : 1u; nx = cnt > 0u ? cnt : 1u;
}
__device__ __forceinline__ void xcd_barrier(unsigned* bar, volatile LAS unsigned* st) {
    asm volatile("s_waitcnt vmcnt(0)" ::: "memory");
    __syncthreads();
    if (threadIdx.x == 0) {
        const unsigned x = xb_xcc_id();
        __builtin_amdgcn_s_waitcnt(0);
        unsigned nloc = st[0], nx = st[1];
        if (nloc == 0u) { xcd_barrier_complete(bar, x, nloc, nx); st[0] = nloc; st[1] = nx; }
        const unsigned old = xb_add(&bar[XB_XSUB(x)], 1u);
        const unsigned gen = old / nloc;
        if (old + 1u == (gen + 1u) * nloc) {
            __builtin_amdgcn_fence(__ATOMIC_RELEASE, "agent");
            asm volatile("s_waitcnt vmcnt(0)" ::: "memory");
            const unsigned og = xb_add(&bar[XB_TOP], 1u);
            const unsigned tg = og / nx;
            if (og + 1u == (tg + 1u) * nx) xb_add(&bar[XB_TOPGEN], 1u);
            else XB_SPIN(xb_ld(&bar[XB_TOPGEN]) == tg, bar);
            __builtin_amdgcn_fence(__ATOMIC_ACQUIRE, "agent");
            xb_add(&bar[XB_XGEN(x)], 1u);
            asm volatile("s_waitcnt vmcnt(0)" ::: "memory");
        } else {
            XB_SPIN(xb_ld(&bar[XB_XGEN(x)]) == gen, bar);
            __builtin_amdgcn_fence(__ATOMIC_ACQUIRE, "agent");
            asm volatile("s_waitcnt vmcnt(0)" ::: "memory");
        }
    }
    __syncthreads();
}

typedef const __attribute__((address_space(4))) Args* KArgPtr;
__device__ __forceinline__ Args load_args() {
    Args r{};
#if defined(__HIP_DEVICE_COMPILE__)
    KArgPtr p = (KArgPtr)__builtin_amdgcn_kernarg_segment_ptr(); asm volatile("" : "+s"(p));
#pragma unroll
    for (int i = 0; i < 20; ++i) r.in[i] = p->in[i];
    r.out = p->out; r.ws = p->ws; r.ph_lo = p->ph_lo; r.ph_hi = p->ph_hi;
#endif
    return r;
}
__global__ void __launch_bounds__(512, 2) mk_fwd(Args ka) {
    extern __shared__ __attribute__((aligned(16))) unsigned char lds_raw[];
    LAS unsigned char* lds = (LAS unsigned char*)lds_raw;
    cg::grid_group grid = cg::this_grid();
    const int lo = ka.ph_lo, hi = ka.ph_hi, G = gridDim.x, bid = blockIdx.x;
    const int tid = threadIdx.x, lane = tid & 63, wave = tid >> 6;
#ifndef PH_MASK
#define PH_MASK 0x1ff
#endif
#define IN(k) (((PH_MASK >> (k)) & 1) && lo <= (k) && (k) < hi)
#if MK_CG_SYNC
#define SEAM(k) do { if (IN(k) && IN((k) + 1)) grid.sync(); } while (0)
#else
#define SEAM(k) do { if (IN(k) && IN((k) + 1)) xcd_barrier((unsigned*)(ka.ws + WS_CTL), (volatile LAS unsigned*)(lds + LDS_XB)); } while (0)
    if (hi - lo > 1) {
        if (tid == 0) { ((volatile LAS unsigned*)(lds + LDS_XB))[0] = 0u; ((volatile LAS unsigned*)(lds + LDS_XB))[1] = 0u; (void)xb_add((unsigned*)(ka.ws + WS_CTL) + XB_XCNT(xb_xcc_id()), 1u); }
        __syncthreads();
    }
    if (lo > 1000) grid.sync();
#endif
    if (IN(0)) { const Args a = load_args(); p0_phase(a, lds, G);
#if PROBE_DUP & 1
        __syncthreads(); p0_phase(a, lds, G);
#endif
    }
    SEAM(0);
    if (IN(1)) { const Args a = load_args(); p1_phase(a, lds, G);
#if PROBE_DUP & 2
        __syncthreads(); p1_phase(a, lds, G);
#endif
    }
    SEAM(1);
    if (IN(2)) { const Args a = load_args(); OpIn op; op.ws = a.ws; op.lda = 4096; op.ldb = 4096; op.akstep = 128; op.nt = 32; pg8::gemm_phase<OpIn, true>(lds, op, G, bid);
#if PROBE_DUP & 4
        pg8::gemm_phase<OpIn, true>(lds, op, G, bid);
#endif
    }
    SEAM(2);
    if (IN(3)) {
        const Args a = load_args();
        { OpCmp op; op.ws = a.ws; op.lda = 16 * LDPA * 2; op.ldb = 4096; op.akstep = LDPA * 2; op.nt = 32; pg8::gemm_phase<OpCmp, true>(lds, op, G, bid); }
        const int first = (G > 64) ? ((bid >= 32) ? bid - 32 : bid + G - 32) : bid;
#if MK_ONE_LAUNCH
        {
            unsigned* qa = (unsigned*)(a.ws + WS_CTL) + 3600 + 128; volatile LAS unsigned* slot = (volatile LAS unsigned*)(lds + LDS_XB + 8);
            for (;;) { __syncthreads(); if (tid == 0) *slot = __hip_atomic_fetch_add(qa, 1u, __ATOMIC_RELAXED, __HIP_MEMORY_SCOPE_AGENT); __syncthreads();
                const int it = (int)*slot; if (it >= 1024) break; gla_pass_a(a, lds, it); }
        }
#else
        for (int it = first; it < 1024; it += G) gla_pass_a(a, lds, it);
#endif
#if PROBE_DUP & 8
        __syncthreads();
        { OpCmp op; op.ws = a.ws; op.lda = 16 * LDPA * 2; op.ldb = 4096; op.akstep = LDPA * 2; op.nt = 32; pg8::gemm_phase<OpCmp, true>(lds, op, G, bid); }
        for (int it = first; it < 1024; it += G) gla_pass_a(a, lds, it);
#endif
    }
    SEAM(3);
    if (IN(4)) {
        const Args a = load_args();
        for (int it = bid * 8 + wave; it < 512; it += G * 8) cmp2_item(a, it, lane);
#if PROBE_DUP & 16
        for (int it = bid * 8 + wave; it < 512; it += G * 8) cmp2_item(a, it, lane);
        gla_scan(a, G, true);
#endif
        gla_scan(a, G, false);
    }
    SEAM(4);
    if (IN(5)) {
        const Args a = load_args();
#ifndef PROBE_DUP_P5
#define PROBE_DUP_P5 0
#endif
#if MK_ONE_LAUNCH
        {
            unsigned* qn = (unsigned*)(a.ws + WS_CTL) + 3600; unsigned* qg = qn + 64;
            volatile LAS unsigned* slot = (volatile LAS unsigned*)(lds + LDS_XB + 8);
            for (;;) { __syncthreads(); if (tid == 0) *slot = __hip_atomic_fetch_add(qn, 1u, __ATOMIC_RELAXED, __HIP_MEMORY_SCOPE_AGENT); __syncthreads();
                const int it = (int)*slot; if (it >= 1024) break; nsa_item(a, lds, it, (bf16_t*)(a.ws + WS_PA) + PA_Q, LDPA); }
            for (;;) { __syncthreads(); if (tid == 0) *slot = __hip_atomic_fetch_add(qg, 1u, __ATOMIC_RELAXED, __HIP_MEMORY_SCOPE_AGENT); __syncthreads();
                const int it = (int)*slot; if (it >= 1024) break; gla_pass_c(a, lds, it, (bf16_t*)(a.ws + WS_PA) + PA_ZG, LDPA); }
        }
#else
        for (int r = 0; r * G < 1024; ++r) { const int it = r * G + ((r & 1) ? G - 1 - bid : bid); if (it < 1024) nsa_item(a, lds, it, (bf16_t*)(a.ws + WS_PA) + PA_Q, LDPA); }
        for (int it = bid; it < 1024; it += G) gla_pass_c(a, lds, it, (bf16_t*)(a.ws + WS_PA) + PA_ZG, LDPA);
#endif
        __syncthreads();
    }
    SEAM(5);
    if (IN(6)) { const Args a = load_args(); OpMerge op; op.ws = a.ws; op.lda = LDPA * 2; op.ldb = 4096; op.akstep = 128; op.nt = 16; pg8::gemm_phase<OpMerge, true>(lds, op, G, bid);
#if PROBE_DUP & 64
        pg8::gemm_phase<OpMerge, true>(lds, op, G, bid);
#endif
    }
    SEAM(6);
    if (IN(7)) { const Args a = load_args(); OpOut op; op.ws = a.ws; op.x = a.in[0]; op.out = a.out; op.lda = 4096; op.ldb = 4096; op.akstep = 128; op.nt = 32; pg8::gemm_phase<OpOut, true>(lds, op, G, bid);
#if PROBE_DUP & 128
        pg8::gemm_phase<OpOut, true>(lds, op, G, bid);
#endif
    }
    SEAM(7);
#ifdef PROBE_SYNC
    if (IN(7) && IN(8)) { for (int i = 0; i < PROBE_SYNC; ++i) xcd_barrier((unsigned*)(ka.ws + WS_CTL), (volatile LAS unsigned*)(lds + LDS_XB)); }
#endif
    if (IN(8)) { const Args a = load_args();
#if PROBE_DUP & 256
        final_norm(a, G, (float*)(a.ws + WS_PA));
#endif
        final_norm(a, G, a.out); }
#ifdef DBG
    if (lo == 9) {
        const Args a = load_args(); unsigned char* ws = a.ws;
        for (size_t i = (size_t)bid * 512 + tid; i < (size_t)NTOK * DM; i += (size_t)G * 512) {
            float v = 0.f;
#if DBG == 1
            v += bf2f(((const bf16_t*)(ws + WS_PA))[i % ((size_t)NTOK * LDPA)]) + bf2f(((const bf16_t*)(ws + WS_PA))[(i + 33554432) % ((size_t)NTOK * LDPA)]) + bf2f(((const bf16_t*)(ws + WS_PA))[(i + 50331648) % ((size_t)NTOK * LDPA)]);
            v += bf2f(((const bf16_t*)(ws + WS_PB))[i]) + bf2f(((const bf16_t*)(ws + WS_PB))[i + 33554432]);
            v += ((const float*)(ws + WS_SM))[i % (16384 * 64)];
            v += bf2f(((const bf16_t*)(ws + WS_SVT))[i % (2 * 256 * 8192)]) + bf2f(((const bf16_t*)(ws + WS_WVT))[i % (2 * 256 * 8192)]) + bf2f(((const bf16_t*)(ws + WS_GVT))[i % (2 * 1024 * 8192)]);
#elif DBG == 2
            v += bf2f(((const bf16_t*)(ws + WS_KC))[i % (8 * 512 * 64)]) + bf2f(((const bf16_t*)(ws + WS_VCT))[i % (8 * 512 * 64)]) + bf2f(((const bf16_t*)(ws + WS_HB))[i]) + ((const float*)(ws + WS_GAM))[i % (8 * 128 * 128)];
#elif DBG == 5
            v += bf2f(((const bf16_t*)(ws + WS_KC))[i % (8 * 512 * 64)]) + bf2f(((const bf16_t*)(ws + WS_VCT))[i % (8 * 512 * 64)]) + bf2f(((const bf16_t*)(ws + WS_HID))[i % (2 * 4096 * 256)]);
#elif DBG == 6 || DBG == 7
            v += bf2f(((const bf16_t*)(ws + WS_HB))[i]) + ((const float*)(ws + WS_GAM))[i % (8 * 128 * 128)];
#elif DBG == 8
            v += ((const float*)(ws + WS_GAM))[i % (8 * 128 * 128)];
#elif DBG == 3
            v += bf2f(((const bf16_t*)(ws + WS_PA))[(i / 2048) * LDPA + (i % 2048 < 1024 ? i % 1024 : 4096 + i % 1024)]);
#elif DBG == 4
            v += bf2f(((const bf16_t*)(ws + WS_HB))[i]);
#endif
            a.out[i] = v;
        }
    }
#endif
}

extern "C" void kernel_launch(void* const* d_in, const int* in_sizes, int n_in, void* d_out, int out_size, void* d_ws, size_t ws_size, hipStream_t stream) {
    static int grid = 0;
    if (grid == 0) {
        if (n_in != 20 || out_size != NTOK * DM || ws_size < WS_END) { fprintf(stderr, "kernel_launch: unexpected problem (n_in %d out %d ws %zu need %zu)\n", n_in, out_size, ws_size, (size_t)WS_END); grid = -1; return; }
        int dev = 0, cus = 0, per_cu = 0;
        hipGetDevice(&dev); hipDeviceGetAttribute(&cus, hipDeviceAttributeMultiprocessorCount, dev);
        if (hipFuncSetAttribute((const void*)mk_fwd, hipFuncAttributeMaxDynamicSharedMemorySize, LDS_BYTES) != hipSuccess) { fprintf(stderr, "kernel_launch: hipFuncSetAttribute failed\n"); grid = -1; return; }
        if (hipOccupancyMaxActiveBlocksPerMultiprocessor(&per_cu, (const void*)mk_fwd, 512, LDS_BYTES) != hipSuccess || per_cu < 1) { fprintf(stderr, "kernel_launch: occupancy query failed (%d)\n", per_cu); per_cu = 1; }
        (void)hipGetLastError();
        grid = cus * per_cu;
        fprintf(stderr, "kernel_launch: grid %d (cus %d x %d)\n", grid, cus, per_cu);
    }
    if (grid < 0) return;
    Args a{};
    for (int i = 0; i < 20; ++i) a.in[i] = (const float*)d_in[i];
    a.out = (float*)d_out; a.ws = (unsigned char*)d_ws;
#if MK_ONE_LAUNCH
    a.ph_lo = 0; a.ph_hi = 9;
    if (hipMemsetAsync((char*)d_ws + WS_CTL, 0, 16384, stream) != hipSuccess) { fprintf(stderr, "kernel_launch: memset of the barrier words failed\n"); return; }
    void* args[] = {&a};
    hipError_t e = hipLaunchCooperativeKernel((const void*)mk_fwd, dim3(grid), dim3(512), args, LDS_BYTES, stream);
    if (e != hipSuccess) fprintf(stderr, "cooperative launch failed: %s (grid %d)\n", hipGetErrorString(e), grid);
#else
#ifdef DBG
    const int plast = (DBG == 7 || DBG == 8) ? 4 : (DBG == 1) ? 3 : (DBG == 2 || DBG == 5 || DBG == 6) ? 5 : (DBG == 3) ? 6 : 7;
    for (int p = 0; p < plast; ++p) { a.ph_lo = p; a.ph_hi = p + 1; hipLaunchKernelGGL(mk_fwd, dim3(grid), dim3(512), LDS_BYTES, stream, a); }
    a.ph_lo = 9; a.ph_hi = 10; hipLaunchKernelGGL(mk_fwd, dim3(grid), dim3(512), LDS_BYTES, stream, a);
#else
    for (int p = 0; p < 9; ++p) { a.ph_lo = p; a.ph_hi = p + 1; hipLaunchKernelGGL(mk_fwd, dim3(grid), dim3(512), LDS_BYTES, stream, a); }
#endif
#endif
}
```
